# Optimizing an MI355X kernel written in HIP

```python
import jax, jax.numpy as jnp
from jax import lax
import numpy as np

D_MODEL = 1024
BATCH = 4
SEQ = 4096
DEPTH = 2

MIX_WIDTH = D_MODEL
MLSTM_HEADS = 4
MLSTM_WIDTH = MIX_WIDTH // 2
MLSTM_V_DIM = MLSTM_WIDTH // MLSTM_HEADS
MLSTM_QK_DIM = MLSTM_V_DIM // 2
QK_WIDTH = MLSTM_HEADS * MLSTM_QK_DIM
QK_CONV = 4
CHUNK = 64
POOL_WIDTH = MIX_WIDTH - MLSTM_WIDTH
POOL_WINDOWS = (2, 4, 8, 16)
POOL_GROUPS = len(POOL_WINDOWS)
POOL_GROUP_DIM = POOL_WIDTH // POOL_GROUPS
D_FF = 2816
FFN_CONV = 3
EPS = 1e-6
SPLITS = (2 * QK_WIDTH,
          2 * QK_WIDTH + MLSTM_WIDTH,
          2 * QK_WIDTH + 2 * MLSTM_WIDTH,
          2 * QK_WIDTH + 2 * MLSTM_WIDTH + 2 * MLSTM_HEADS)
IN_WIDTH = SPLITS[-1] + POOL_WIDTH

kernel_name = "hymba_mlstm_multiscale_pool_convffn"


def rmsnorm(x, g):
    xf = x.astype(jnp.float32)
    y = xf * lax.rsqrt(jnp.mean(xf * xf, axis=-1, keepdims=True) + EPS)
    return (y * g.astype(jnp.float32)).astype(x.dtype)


def causal_dwconv(x, w):
    K = w.shape[0]
    T = x.shape[1]
    xp = jnp.pad(x, ((0, 0), (K - 1, 0), (0, 0)))
    return sum(xp[:, j:j + T] * w[j] for j in range(K))


def mlstm_chunkwise(q, k, v, i_pre, f_pre):
    B, T, H, dk = q.shape
    dv = v.shape[-1]
    nc = T // CHUNK
    f32 = jnp.float32

    def chunks(a):
        a = a.reshape((B, nc, CHUNK, H) + a.shape[3:])
        return jnp.moveaxis(a, 3, 1)

    qc = chunks(q.astype(f32))
    kc = chunks(k.astype(f32)) * (dk ** -0.5)
    vc = chunks(v.astype(f32))
    ig = chunks(i_pre.astype(f32))
    lf = jax.nn.log_sigmoid(chunks(f_pre.astype(f32)))
    b = jnp.cumsum(lf, axis=-1)
    b_last = b[..., -1]

    a = b_last[..., None] - b + ig
    m_loc = jnp.max(a, axis=-1)
    wgt = jnp.exp(a - m_loc[..., None])
    c_loc = jnp.einsum('bhcs,bhcsk,bhcsv->bhckv', wgt, kc, vc)
    n_loc = jnp.einsum('bhcs,bhcsk->bhck', wgt, kc)

    def step(carry, inp):
        c, n, m = carry
        g, ml, cl, nl = inp
        m_new = jnp.maximum(g + m, ml)
        s_prev = jnp.exp(g + m - m_new)
        s_loc = jnp.exp(ml - m_new)
        c_new = s_prev[..., None, None] * c + s_loc[..., None, None] * cl
        n_new = s_prev[..., None] * n + s_loc[..., None] * nl
        return (c_new, n_new, m_new), (c, n, m)

    init = (jnp.zeros((B, H, dk, dv), f32), jnp.zeros((B, H, dk), f32), jnp.zeros((B, H), f32))
    xs = (jnp.moveaxis(b_last, 2, 0), jnp.moveaxis(m_loc, 2, 0),
          jnp.moveaxis(c_loc, 2, 0), jnp.moveaxis(n_loc, 2, 0))
    _, (c_prev, n_prev, m_prev) = lax.scan(step, init, xs)
    c_prev = jnp.moveaxis(c_prev, 0, 2)
    n_prev = jnp.moveaxis(n_prev, 0, 2)
    m_prev = jnp.moveaxis(m_prev, 0, 2)

    causal = np.tril(np.ones((CHUNK, CHUNK), dtype=bool))
    log_d = jnp.where(causal, b[..., :, None] - b[..., None, :] + ig[..., None, :], -jnp.inf)
    m_inter = b + m_prev[..., None]
    m = jnp.maximum(m_inter, jnp.max(log_d, axis=-1))
    dmat = jnp.exp(log_d - m[..., None])
    s = jnp.einsum('bhcjk,bhcsk->bhcjs', qc, kc) * dmat
    sc = jnp.exp(m_inter - m)
    num = (jnp.einsum('bhcjs,bhcsv->bhcjv', s, vc)
           + sc[..., None] * jnp.einsum('bhcjk,bhckv->bhcjv', qc, c_prev))
    den = jnp.sum(s, axis=-1) + sc * jnp.einsum('bhcjk,bhck->bhcj', qc, n_prev)
    h = num / jnp.maximum(jnp.abs(den), jnp.exp(-m))[..., None]
    h = jnp.moveaxis(h, 1, 3).reshape(B, T, H, dv)
    return h.astype(v.dtype)


def head_rmsnorm(h, g):
    B, T, H, dv = h.shape
    hf = h.astype(jnp.float32)
    y = hf * lax.rsqrt(jnp.mean(hf * hf, axis=-1, keepdims=True) + EPS)
    return (y.reshape(B, T, H * dv) * g.astype(jnp.float32)).astype(h.dtype)


def multiscale_pool(u, w_pool, pool_scale):
    B, T, _ = u.shape
    uf = u.astype(jnp.float32).reshape(B, T, POOL_GROUPS, POOL_GROUP_DIM)
    cs = jnp.pad(jnp.cumsum(uf, axis=1), ((0, 0), (1, 0), (0, 0), (0, 0)))
    pos = jnp.arange(1, T + 1, dtype=jnp.float32)
    outs = []
    for g, w in enumerate(POOL_WINDOWS):
        c = cs[:, :, g]
        lag = jnp.pad(c, ((0, 0), (w, 0), (0, 0)))[:, 1:T + 1]
        mean = (c[:, 1:] - lag) / jnp.minimum(pos, float(w))[None, :, None]
        outs.append(mean - uf[:, :, g])
    d = jnp.stack(outs, axis=2)
    y = jnp.einsum('btgc,gcd->btgd', d, w_pool.astype(jnp.float32)).reshape(B, T, POOL_WIDTH)
    return (y * pool_scale.astype(jnp.float32)).astype(u.dtype)


def hybrid_layer(x, g_mix, w_in, b_gates, w_qk_conv, g_head, w_pool, pool_scale, w_out,
                 g_ffn, w_up, w_ffn_conv, b_ffn_conv, w_down):
    B, T, _ = x.shape
    h = rmsnorm(x, g_mix)
    p = h @ w_in
    qk, v, o, gates, u = jnp.split(p, SPLITS, axis=-1)
    qk = jax.nn.silu(causal_dwconv(qk, w_qk_conv))
    q, k = qk[..., :QK_WIDTH], qk[..., QK_WIDTH:]
    gates = gates + b_gates
    i_pre, f_pre = gates[..., :MLSTM_HEADS], gates[..., MLSTM_HEADS:]
    hm = mlstm_chunkwise(q.reshape(B, T, MLSTM_HEADS, MLSTM_QK_DIM),
                         k.reshape(B, T, MLSTM_HEADS, MLSTM_QK_DIM),
                         v.reshape(B, T, MLSTM_HEADS, MLSTM_V_DIM), i_pre, f_pre)
    hm = head_rmsnorm(hm, g_head) * jax.nn.sigmoid(o)
    hp = multiscale_pool(u, w_pool, pool_scale)
    x = x + jnp.concatenate([hm, hp], axis=-1) @ w_out
    h = rmsnorm(x, g_ffn)
    up = causal_dwconv(h @ w_up, w_ffn_conv) + b_ffn_conv
    gate, val = up[..., :D_FF], up[..., D_FF:]
    return x + (jax.nn.silu(gate) * val) @ w_down


def setup_inputs(seed: int = 0) -> dict:
    key = jax.random.key(seed)
    ks = jax.random.split(key, 16)
    f32 = jnp.float32
    nrm = lambda k, shape, s: (jax.random.normal(k, shape, f32) * s).astype(f32)
    f_bias = jnp.broadcast_to(jnp.linspace(3.0, 6.0, MLSTM_HEADS, dtype=f32), (DEPTH, MLSTM_HEADS))
    b_gates = jnp.concatenate([nrm(ks[3], (DEPTH, MLSTM_HEADS), 0.1),
                               f_bias + nrm(ks[4], (DEPTH, MLSTM_HEADS), 0.1)], axis=-1)
    return {
        "x": nrm(ks[0], (BATCH, SEQ, D_MODEL), 1.0),
        "mix_norm": 1.0 + nrm(ks[1], (DEPTH, D_MODEL), 0.02),
        "w_in": nrm(ks[2], (DEPTH, D_MODEL, IN_WIDTH), D_MODEL ** -0.5),
        "b_gates": b_gates,
        "w_qk_conv": nrm(ks[5], (DEPTH, QK_CONV, 2 * QK_WIDTH), QK_CONV ** -0.5),
        "head_norm": 1.0 + nrm(ks[6], (DEPTH, MLSTM_WIDTH), 0.02),
        "w_pool": nrm(ks[7], (DEPTH, POOL_GROUPS, POOL_GROUP_DIM, POOL_GROUP_DIM), POOL_GROUP_DIM ** -0.5),
        "pool_scale": 1.0 + nrm(ks[8], (DEPTH, POOL_WIDTH), 0.02),
        "w_out": nrm(ks[9], (DEPTH, MIX_WIDTH, D_MODEL), MIX_WIDTH ** -0.5),
        "ffn_norm": 1.0 + nrm(ks[10], (DEPTH, D_MODEL), 0.02),
        "w_up": nrm(ks[11], (DEPTH, D_MODEL, 2 * D_FF), D_MODEL ** -0.5),
        "w_ffn_conv": nrm(ks[12], (DEPTH, FFN_CONV, 2 * D_FF), FFN_CONV ** -0.5),
        "b_ffn_conv": nrm(ks[13], (DEPTH, 2 * D_FF), 0.02),
        "w_down": nrm(ks[14], (DEPTH, D_FF, D_MODEL), D_FF ** -0.5),
        "final_norm": 1.0 + nrm(ks[15], (D_MODEL,), 0.02),
    }


def reference(x, mix_norm, w_in, b_gates, w_qk_conv, head_norm, w_pool, pool_scale, w_out,
              ffn_norm, w_up, w_ffn_conv, b_ffn_conv, w_down, final_norm):
    for l in range(DEPTH):
        x = hybrid_layer(x, mix_norm[l], w_in[l], b_gates[l], w_qk_conv[l], head_norm[l],
                         w_pool[l], pool_scale[l], w_out[l], ffn_norm[l], w_up[l],
                         w_ffn_conv[l], b_ffn_conv[l], w_down[l])
    return rmsnorm(x, final_norm)
```

```cpp
#include <hip/hip_runtime.h>
#include <hip/hip_cooperative_groups.h>
#include <cstdio>
#include <cstdint>
namespace cg = cooperative_groups;
namespace pg8 {
#define PG8_LAS __attribute__((address_space(3)))
typedef unsigned short bf16_t;
typedef short bf16x8 __attribute__((ext_vector_type(8)));
typedef float f32x4 __attribute__((ext_vector_type(4)));
typedef unsigned u32x4 __attribute__((ext_vector_type(4)));
constexpr int BM = 256, BK = 64, HALF = 128, HTB = HALF * BK * 2  , STAGE_BYTES = 8 * HTB, NXCD = 8;

__host__ __device__ __forceinline__ int lds_byte(int r, int c) { const int st = (r >> 4) * 2 + (c >> 5), rr = r & 15, cc = c & 31, ob = rr * 64 + cc * 2; return st * 1024 + (ob ^ (((ob >> 9) & 1) << 5)); }
__host__ __device__ __forceinline__ void stage_rc(int b, int& R, int& C) { const int st = b / 1024, sb = b % 1024, swz = sb ^ (((sb >> 9) & 1) << 5); R = (st >> 1) * 16 + swz / 64; C = (st & 1) * 32 + (swz % 64) / 2; }
__host__ __device__ __forceinline__ int perm32(int rho) { const int n = rho >> 4, i = rho & 15; return 8 * (i >> 2) + 4 * n + (i & 3); }

struct Unit { int pm, pn; };
struct Gemm { const bf16_t* A; const bf16_t* Bt; int M, N, K; };

struct StaticOrder {
    int nM, nN, nwg, G, c, WGM;
    __host__ __device__ void init(int M, int N, int G_, int c_, int wgm = 4) { nM = M / BM; nN = N / BM; nwg = nM * nN; G = G_; c = c_; WGM = wgm; }
    __host__ __device__ bool next(int i, Unit& u) const {
        const long L = (long)i * G + c; if (L >= nwg) return false;
        int wgid = (int)L; { const int q = nwg / NXCD, r = nwg % NXCD, xcd = wgid % NXCD, off = wgid / NXCD; wgid = (xcd < r ? xcd * (q + 1) : r * (q + 1) + (xcd - r) * q) + off; }
        const int nig = WGM * nN, gid = wgid / nig, fm = gid * WGM, gsz = (nM - fm) < WGM ? (nM - fm) : WGM;
        u.pm = fm + ((wgid % nig) % gsz); u.pn = (wgid % nig) / gsz; return true;
    }
    __device__ __forceinline__ void a_ready(const Unit&) const {}
    __device__ __forceinline__ void done(const Unit&) const {}
};
template <class Epi, class Sched, bool ALIGN_EPI = false, bool SP2 = false>
__device__ __forceinline__ void gemm_phase(PG8_LAS unsigned char* lds, const Gemm g, const Sched& S, const Epi& E, int tid) {
    asm volatile("" : "+v"(tid));
    const int wid = __builtin_amdgcn_readfirstlane(tid >> 6), lane = tid & 63, wr = wid >> 2, wc = wid & 3, fr = lane & 15, fq = lane >> 4;
    const int K = g.K, nt = K / BK;
    unsigned voffA[2], voffB[2];
#pragma unroll
    for (int i = 0; i < 2; ++i) { int R, C; stage_rc(tid * 16 + i * 8192, R, C); const int Rb = Epi::PERM ? ((R & ~31) + perm32(R & 31)) : R;
        const int Ra = Epi::ROWPERM ? ((((R >> 6) * 16 + (R & 15)) * 8) + ((R >> 4) & 3)) : R;
        voffA[i] = (unsigned)(Ra * K + C) * 2u; voffB[i] = (unsigned)(Rb * K + C) * 2u; }
    const size_t kstep = (size_t)(BK * 2);
    const size_t hstepB = (size_t)HALF * K * 2;
    const size_t hstepA = Epi::ROWPERM ? (size_t)4 * K * 2 : hstepB;
    const size_t tstep = 2 * hstepB;
    const unsigned ldsw = (unsigned)wid * 1024u;
    const int aoff = lds_byte(wr * 64 + fr, fq * 8), boff = lds_byte(wc * 32 + fr, fq * 8);
#define PG8_SA(b, h) (((b) * 2 + (h)) * HTB)
#define PG8_SB(b, h) ((4 + (b) * 2 + (h)) * HTB)
#define PG8_STAGE(bufoff, gbase, voff) do { _Pragma("unroll") for (int _i = 0; _i < 2; ++_i) \
        __builtin_amdgcn_global_load_lds((const unsigned*)((const char*)(gbase) + (voff)[_i]), (PG8_LAS unsigned*)(lds + (bufoff) + ldsw + _i * 8192), 16, 0, 0); } while (0)
#define PG8_LDA(dst, b, h) do { _Pragma("unroll") for (int m = 0; m < 4; ++m) _Pragma("unroll") for (int k = 0; k < 2; ++k) dst[m][k] = *(const PG8_LAS bf16x8*)(lds + PG8_SA(b, h) + aoff + m * 2048 + k * 1024); } while (0)
#define PG8_LDB(dst, b, h) do { _Pragma("unroll") for (int n = 0; n < 2; ++n) _Pragma("unroll") for (int k = 0; k < 2; ++k) dst[n][k] = *(const PG8_LAS bf16x8*)(lds + PG8_SB(b, h) + boff + n * 2048 + k * 1024); } while (0)
#define PG8_MMA(ai, bj, At, Bt) do { __builtin_amdgcn_s_setprio(1); _Pragma("unroll") for (int m = 0; m < 4; ++m) _Pragma("unroll") for (int n = 0; n < 2; ++n) _Pragma("unroll") for (int k = 0; k < 2; ++k) \
        acc[ai][bj][m][n] = __builtin_amdgcn_mfma_f32_16x16x32_bf16(Bt[n][k], At[m][k], acc[ai][bj][m][n], 0, 0, 0); __builtin_amdgcn_s_setprio(0); } while (0)
#define PG8_WAIT_V(n) asm volatile("s_waitcnt vmcnt(" #n ")" ::: "memory")
#define PG8_WAIT_L(n) asm volatile("s_waitcnt lgkmcnt(" #n ")" ::: "memory")
#define PG8_BAR __builtin_amdgcn_s_barrier()
#define PG8_SCHED __builtin_amdgcn_sched_barrier(0)
    Unit cur, nxt; int ui = 0;
    if (!S.next(0, cur)) return;
    f32x4 acc[2][2][4][2];
#pragma unroll
    for (int a = 0; a < 2; ++a)
#pragma unroll
        for (int b = 0; b < 2; ++b)
#pragma unroll
            for (int m = 0; m < 4; ++m)
#pragma unroll
                for (int n = 0; n < 2; ++n) acc[a][b][m][n] = (f32x4){0.f, 0.f, 0.f, 0.f};
    bf16x8 At[4][2], B0[2][2], B1[2][2];
    const char* cA = (const char*)g.A + (size_t)cur.pm * tstep; const char* cB = (const char*)g.Bt + (size_t)cur.pn * tstep;
    if constexpr (SP2) {
        PG8_STAGE(PG8_SB(0, 0), cB, voffB); PG8_STAGE(PG8_SB(0, 1), cB + hstepB, voffB); PG8_STAGE(PG8_SA(0, 0), cA, voffA); PG8_STAGE(PG8_SA(0, 1), cA + hstepA, voffA);
        if (wr == 1) PG8_BAR;
        PG8_WAIT_V(2); PG8_BAR;
        PG8_STAGE(PG8_SB(1, 0), cB + kstep, voffB); PG8_STAGE(PG8_SA(1, 0), cA + kstep, voffA); PG8_STAGE(PG8_SB(1, 1), cB + hstepB + kstep, voffB);
        PG8_WAIT_V(6); PG8_BAR;
    } else {
        PG8_STAGE(PG8_SB(0, 0), cB, voffB); PG8_STAGE(PG8_SA(0, 0), cA, voffA); PG8_STAGE(PG8_SB(0, 1), cB + hstepB, voffB); PG8_STAGE(PG8_SA(0, 1), cA + hstepA, voffA);
        if (wr == 1) PG8_BAR;
        PG8_WAIT_V(4); PG8_BAR;
        PG8_STAGE(PG8_SB(1, 0), cB + kstep, voffB); PG8_STAGE(PG8_SA(1, 0), cA + kstep, voffA); PG8_STAGE(PG8_SB(1, 1), cB + hstepB + kstep, voffB);
        PG8_WAIT_V(6); PG8_BAR;
    }
    for (;;) {
        const bool has_next = S.next(ui + 1, nxt);
        const char* nA = has_next ? (const char*)g.A + (size_t)nxt.pm * tstep : cA; const char* nB = has_next ? (const char*)g.Bt + (size_t)nxt.pn * tstep : cB;
        for (int t = 0; t < nt; t += 2) {
            const bool last = (t == nt - 2);
            const char* a1 = cA + (size_t)(t + 1) * kstep;
            const char* a2 = last ? nA : cA + (size_t)(t + 2) * kstep; const char* b2 = last ? nB : cB + (size_t)(t + 2) * kstep;
            const char* a3 = a2 + kstep; const char* b3 = b2 + kstep;
            if constexpr (SP2) {
            PG8_LDB(B0, 0, 0); PG8_LDB(B1, 0, 1); PG8_SCHED; PG8_LDA(At, 0, 0); PG8_STAGE(PG8_SA(1, 1), a1 + hstepA, voffA);
            PG8_WAIT_V(8); PG8_WAIT_L(0); PG8_BAR; PG8_MMA(0, 0, At, B0); PG8_MMA(0, 1, At, B1); PG8_BAR; PG8_SCHED;
            PG8_LDA(At, 0, 1); PG8_STAGE(PG8_SB(0, 0), b2, voffB); PG8_STAGE(PG8_SB(0, 1), b2 + hstepB, voffB); PG8_STAGE(PG8_SA(0, 0), a2, voffA);
            PG8_WAIT_V(8); PG8_WAIT_L(0); PG8_BAR; PG8_MMA(1, 0, At, B0); PG8_MMA(1, 1, At, B1); PG8_BAR; PG8_SCHED;
            PG8_LDB(B0, 1, 0); PG8_LDB(B1, 1, 1); PG8_SCHED; PG8_LDA(At, 1, 0); PG8_STAGE(PG8_SA(0, 1), a2 + hstepA, voffA);
            PG8_WAIT_V(8); PG8_WAIT_L(0); PG8_BAR; PG8_MMA(0, 0, At, B0); PG8_MMA(0, 1, At, B1); PG8_BAR; PG8_SCHED;
            PG8_LDA(At, 1, 1); PG8_STAGE(PG8_SB(1, 0), b3, voffB); PG8_STAGE(PG8_SB(1, 1), b3 + hstepB, voffB); PG8_STAGE(PG8_SA(1, 0), a3, voffA);
            PG8_WAIT_V(8); PG8_WAIT_L(0); PG8_BAR; PG8_MMA(1, 0, At, B0); PG8_MMA(1, 1, At, B1); PG8_BAR; PG8_SCHED;
            } else {
            PG8_LDB(B0, 0, 0); PG8_SCHED; PG8_LDA(At, 0, 0); PG8_STAGE(PG8_SA(1, 1), a1 + hstepA, voffA);
            PG8_WAIT_L(8); PG8_BAR; PG8_WAIT_L(0); PG8_MMA(0, 0, At, B0); PG8_BAR; PG8_SCHED;
            PG8_LDB(B1, 0, 1); PG8_STAGE(PG8_SB(0, 0), b2, voffB);
            PG8_BAR; PG8_WAIT_L(0); PG8_MMA(0, 1, At, B1); PG8_BAR;
            PG8_LDA(At, 0, 1); PG8_STAGE(PG8_SA(0, 0), a2, voffA);
            PG8_BAR; PG8_WAIT_L(0); PG8_MMA(1, 0, At, B0); PG8_BAR; PG8_SCHED;
            PG8_STAGE(PG8_SB(0, 1), b2 + hstepB, voffB);
            PG8_WAIT_V(6); PG8_BAR; PG8_MMA(1, 1, At, B1); PG8_BAR;
            PG8_LDB(B0, 1, 0); PG8_SCHED; PG8_LDA(At, 1, 0); PG8_STAGE(PG8_SA(0, 1), a2 + hstepA, voffA);
            PG8_WAIT_L(8); PG8_BAR; PG8_WAIT_L(0); PG8_MMA(0, 0, At, B0); PG8_BAR; PG8_SCHED;
            PG8_LDB(B1, 1, 1); PG8_STAGE(PG8_SB(1, 0), b3, voffB);
            PG8_BAR; PG8_WAIT_L(0); PG8_MMA(0, 1, At, B1); PG8_BAR;
            PG8_LDA(At, 1, 1); PG8_STAGE(PG8_SA(1, 0), a3, voffA);
            PG8_BAR; PG8_WAIT_L(0); PG8_MMA(1, 0, At, B0); PG8_BAR; PG8_SCHED;
            PG8_STAGE(PG8_SB(1, 1), b3 + hstepB, voffB);
            PG8_WAIT_V(6); PG8_BAR; PG8_MMA(1, 1, At, B1); PG8_BAR;
            }
        }
        if constexpr (ALIGN_EPI) { if (wr == 0) PG8_BAR; }
        E(acc, cur, wr, wc, fr, fq, lds, ui);
        if (!has_next) break;
#pragma unroll
        for (int a = 0; a < 2; ++a)
#pragma unroll
            for (int b = 0; b < 2; ++b)
#pragma unroll
                for (int m = 0; m < 4; ++m)
#pragma unroll
                    for (int n = 0; n < 2; ++n) acc[a][b][m][n] = (f32x4){0.f, 0.f, 0.f, 0.f};
        cur = nxt; cA = nA; cB = nB; ++ui;
        if constexpr (ALIGN_EPI) { if (wr == 1) PG8_BAR; }
    }
    PG8_WAIT_V(0);
    if constexpr (!ALIGN_EPI) { if (wr == 0) PG8_BAR; }
    PG8_BAR;
#undef PG8_SA
#undef PG8_SB
#undef PG8_STAGE
#undef PG8_LDA
#undef PG8_LDB
#undef PG8_MMA
#undef PG8_WAIT_V
#undef PG8_WAIT_L
#undef PG8_BAR
#undef PG8_SCHED
}
}

#define LAS __attribute__((address_space(3)))
typedef unsigned short bf16_t;
typedef float f32x4 __attribute__((ext_vector_type(4)));
typedef unsigned u32x4 __attribute__((ext_vector_type(4)));
typedef unsigned u32x2 __attribute__((ext_vector_type(2)));

constexpr int D = 1024, BATCH = 4, SEQ = 4096, M = BATCH * SEQ;
constexpr int NH = 4, DV = 128, DK = 64, CH = 64, NCH = SEQ / CH;
constexpr int NP = 2048, DFF = 2816, INW = 2056;
constexpr int NUNIT = BATCH * NH * NCH;
constexpr float EPS = 1e-6f;
constexpr int NT = 512, NWAVES = 8;

constexpr size_t MiB = 1u << 20;
constexpr size_t WS_WIN = 0, WS_WOUT = 4 * MiB, WS_WUP = 6 * MiB, WS_WDN = 17 * MiB;
constexpr size_t WS_WL1 = 100 * MiB;
constexpr size_t WS_FSLOT = 124 * MiB;
constexpr size_t WS_FCNT = 31 * MiB + 16384;
constexpr size_t WS_SMALL = 23 * MiB;
constexpr size_t WS_WG = WS_SMALL;
constexpr size_t WS_G = WS_SMALL + 64 * 1024;
constexpr size_t WS_SS = 80 * MiB;
constexpr size_t WS_BL = WS_G + 512 * 1024 + 320 * 1024;
constexpr size_t WS_ML = WS_BL + 4096;
constexpr size_t WS_MP = WS_ML + 4096;
constexpr size_t WS_NST = WS_SMALL + 1 * MiB;
constexpr size_t WS_WPT = WS_SMALL + 1 * MiB + 256 * 1024;
constexpr size_t WS_QKC = 84 * MiB;
constexpr size_t WS_CPB = 64 * MiB;
constexpr size_t WS_HEAD = WS_SMALL + 2 * MiB;
constexpr size_t WS_TAIL = WS_SMALL + 5 * MiB;
constexpr size_t WS_XN = 32 * MiB;
constexpr size_t WS_XA = 64 * MiB;
constexpr size_t WS_P = 128 * MiB;
constexpr size_t WS_CST = 192 * MiB;
constexpr size_t WS_HCAT = 224 * MiB;
constexpr size_t WS_ACT = 128 * MiB;
constexpr size_t WS_END = 256 * MiB;
constexpr int LDS_BYTES = 163840;
constexpr int RST_OFF = 131072;
constexpr int XCH_OFF = 155648;
constexpr int MISC_OFF = 159744;
constexpr size_t WS_CTL = 31 * MiB;

struct Params { const float* in[15]; float* out; unsigned char* ws; };

__device__ __forceinline__ float bf_lo(unsigned w) { return __uint_as_float(w << 16); }
__device__ __forceinline__ float bf_hi(unsigned w) { return __uint_as_float(w & 0xffff0000u); }
__device__ __forceinline__ unsigned pk_bf16(float lo, float hi) { unsigned r; asm volatile("v_cvt_pk_bf16_f32 %0, %1, %2" : "=v"(r) : "v"(lo), "v"(hi)); return r; }
__device__ __forceinline__ void unpack8(const u32x4 w, float (&x)[8]) { x[0] = bf_lo(w.x); x[1] = bf_hi(w.x); x[2] = bf_lo(w.y); x[3] = bf_hi(w.y); x[4] = bf_lo(w.z); x[5] = bf_hi(w.z); x[6] = bf_lo(w.w); x[7] = bf_hi(w.w); }
__device__ __forceinline__ float shfl_idx(float v, int src) { return __builtin_bit_cast(float, __builtin_amdgcn_ds_bpermute(src << 2, __builtin_bit_cast(int, v))); }
__device__ __forceinline__ float wave_sum(float v, int lane) {
#pragma unroll
    for (int o = 1; o < 64; o <<= 1) v += shfl_idx(v, lane ^ o);
    return v;
}
__device__ __forceinline__ float wave_max(float v, int lane) {
#pragma unroll
    for (int o = 1; o < 64; o <<= 1) v = fmaxf(v, shfl_idx(v, lane ^ o));
    return v;
}
__device__ __forceinline__ float wave_incl_sum(float v, int lane) {
#pragma unroll
    for (int o = 1; o < 64; o <<= 1) { const float t = shfl_idx(v, lane - o); if (lane >= o) v += t; }
    return v;
}
__device__ __forceinline__ float wave_incl_max(float v, int lane) {
#pragma unroll
    for (int o = 1; o < 64; o <<= 1) { const float t = shfl_idx(v, lane - o); if (lane >= o) v = fmaxf(v, t); }
    return v;
}
__device__ __forceinline__ float log_sigmoid(float x) { return fminf(x, 0.f) - log1pf(expf(-fabsf(x))); }
__device__ __forceinline__ float sigmoid_f(float x) { return 1.f / (1.f + expf(-x)); }
__device__ __forceinline__ float silu_f(float x) { return x / (1.f + expf(-x)); }
__device__ __forceinline__ float exp_fast(float x) { return __builtin_amdgcn_exp2f(x * 1.44269504f); }
__device__ __forceinline__ float sigmoid_fast(float x) { return __builtin_amdgcn_rcpf(1.f + __builtin_amdgcn_exp2f(x * -1.44269504f)); }
__device__ __forceinline__ float silu_fast(float x) { return x * sigmoid_fast(x); }
#define LDS_WAIT() asm volatile("s_waitcnt lgkmcnt(0)" ::: "memory")
__device__ __forceinline__ float ss_row(const float* SS, int row) { const f32x4 v = *(const f32x4*)(SS + (size_t)row * 4); return (v[0] + v[1]) + (v[2] + v[3]); }

struct EpiIn {
    static constexpr bool PERM = true, ROWPERM = false;
    bf16_t* P; const float* SS;
    __device__ __forceinline__ void operator()(pg8::f32x4 (&acc)[2][2][4][2], const pg8::Unit& u, int wr, int wc, int fr, int fq, PG8_LAS unsigned char*, int) const {
        const int row0 = u.pm * 256 + wr * 64 + fr, col0 = u.pn * 256 + wc * 32 + 8 * fq;
#pragma unroll
        for (int ai = 0; ai < 2; ++ai)
#pragma unroll
            for (int m = 0; m < 4; ++m) {
                const int row = row0 + ai * 128 + m * 16;
                const float rs = rsqrtf(ss_row(SS, row) * (1.f / D) + EPS);
                bf16_t* rowp = P + (size_t)row * NP + col0;
#pragma unroll
                for (int bj = 0; bj < 2; ++bj) {
                    const pg8::f32x4 v0 = acc[ai][bj][m][0] * rs, v1 = acc[ai][bj][m][1] * rs;
                    u32x4 w; w.x = pk_bf16(v0[0], v0[1]); w.y = pk_bf16(v0[2], v0[3]); w.z = pk_bf16(v1[0], v1[1]); w.w = pk_bf16(v1[2], v1[3]);
                    *(u32x4*)(rowp + bj * 128) = w;
                }
            }
    }
};
struct EpiRes {
    static constexpr bool PERM = true, ROWPERM = false;
    bf16_t* xn; float* ss;
    __device__ __forceinline__ void operator()(pg8::f32x4 (&acc)[2][2][4][2], const pg8::Unit& u, int wr, int wc, int fr, int fq, PG8_LAS unsigned char* lds, int ui) const {
        const int row0 = u.pm * 256 + wr * 64 + fr, col0 = u.pn * 256 + wc * 32 + 8 * fq;
        PG8_LAS float* xs = (PG8_LAS float*)(lds + XCH_OFF);
#pragma unroll
        for (int ai = 0; ai < 2; ++ai) {
            u32x4 r[4][2];
#pragma unroll
            for (int m = 0; m < 4; ++m)
#pragma unroll
                for (int bj = 0; bj < 2; ++bj) r[m][bj] = *(const u32x4*)(xn + (size_t)(row0 + ai * 128 + m * 16) * D + col0 + bj * 128);
#pragma unroll
            for (int m = 0; m < 4; ++m) {
                const int row = row0 + ai * 128 + m * 16;
                const size_t off = (size_t)row * D + col0;
                float part = 0.f;
#pragma unroll
                for (int bj = 0; bj < 2; ++bj) {
                    const u32x4 rv = r[m][bj];
                    const pg8::f32x4 o0 = acc[ai][bj][m][0] + (pg8::f32x4){bf_lo(rv.x), bf_hi(rv.x), bf_lo(rv.y), bf_hi(rv.y)};
                    const pg8::f32x4 o1 = acc[ai][bj][m][1] + (pg8::f32x4){bf_lo(rv.z), bf_hi(rv.z), bf_lo(rv.w), bf_hi(rv.w)};
                    u32x4 w; w.x = pk_bf16(o0[0], o0[1]); w.y = pk_bf16(o0[2], o0[3]); w.z = pk_bf16(o1[0], o1[1]); w.w = pk_bf16(o1[2], o1[3]);
                    *(u32x4*)(xn + off + bj * 128) = w;
                    part += ((o0[0] * o0[0] + o0[1] * o0[1]) + (o0[2] * o0[2] + o0[3] * o0[3])) + ((o1[0] * o1[0] + o1[1] * o1[1]) + (o1[2] * o1[2] + o1[3] * o1[3]));
                }
                { const int ln = fq * 16 + fr; part += shfl_idx(part, ln ^ 16); part += shfl_idx(part, ln ^ 32); }
                if (fq == 0) xs[(ai * 128 + wr * 64 + m * 16 + fr) * 4 + wc] = part;
            }
            asm volatile("" ::: "memory");
        }
        LDS_WAIT(); __builtin_amdgcn_s_barrier(); asm volatile("" ::: "memory");
        if (wr == 0) { const int r = wc * 64 + fq * 16 + fr; const pg8::f32x4 v = *(PG8_LAS pg8::f32x4*)(xs + r * 4);
            ss[(size_t)(u.pm * 256 + r) * 4 + u.pn] = (v[0] + v[1]) + (v[2] + v[3]); }
        LDS_WAIT(); __builtin_amdgcn_s_barrier(); asm volatile("" ::: "memory");
    }
};
struct EpiFinal {
    static constexpr bool PERM = true, ROWPERM = false;
    const bf16_t* xn; float* out; const float* gf; float* slots; unsigned* cnt;
    __device__ __forceinline__ void operator()(pg8::f32x4 (&acc)[2][2][4][2], const pg8::Unit& u, int wr, int wc, int fr, int fq, PG8_LAS unsigned char* lds, int ui) const {
        const int row0 = u.pm * 256 + wr * 64 + fr, col0 = u.pn * 256 + wc * 32 + 8 * fq;
        PG8_LAS float* xs = (PG8_LAS float*)(lds + XCH_OFF);
#pragma unroll
        for (int ai = 0; ai < 2; ++ai) {
            u32x4 r[4][2];
#pragma unroll
            for (int m = 0; m < 4; ++m)
#pragma unroll
                for (int bj = 0; bj < 2; ++bj) r[m][bj] = *(const u32x4*)(xn + (size_t)(row0 + ai * 128 + m * 16) * D + col0 + bj * 128);
#pragma unroll
            for (int m = 0; m < 4; ++m) {
                float part = 0.f;
#pragma unroll
                for (int bj = 0; bj < 2; ++bj) {
                    const u32x4 rv = r[m][bj];
                    const pg8::f32x4 o0 = acc[ai][bj][m][0] + (pg8::f32x4){bf_lo(rv.x), bf_hi(rv.x), bf_lo(rv.y), bf_hi(rv.y)};
                    const pg8::f32x4 o1 = acc[ai][bj][m][1] + (pg8::f32x4){bf_lo(rv.z), bf_hi(rv.z), bf_lo(rv.w), bf_hi(rv.w)};
                    acc[ai][bj][m][0] = o0; acc[ai][bj][m][1] = o1;
                    part += ((o0[0] * o0[0] + o0[1] * o0[1]) + (o0[2] * o0[2] + o0[3] * o0[3])) + ((o1[0] * o1[0] + o1[1] * o1[1]) + (o1[2] * o1[2] + o1[3] * o1[3]));
                }
                { const int ln = fq * 16 + fr; part += shfl_idx(part, ln ^ 16); part += shfl_idx(part, ln ^ 32); }
                if (fq == 0) xs[(ai * 128 + wr * 64 + m * 16 + fr) * 4 + wc] = part;
            }
            asm volatile("" ::: "memory");
        }
        LDS_WAIT(); __builtin_amdgcn_s_barrier(); asm volatile("" ::: "memory");
        unsigned* pc = cnt + 64 * u.pm;
        if (wr == 0) {
            const int r = wc * 64 + fq * 16 + fr; const pg8::f32x4 v = *(PG8_LAS pg8::f32x4*)(xs + r * 4);
            __hip_atomic_store(slots + (size_t)u.pn * M + u.pm * 256 + r, (v[0] + v[1]) + (v[2] + v[3]), __ATOMIC_RELAXED, __HIP_MEMORY_SCOPE_AGENT);
            asm volatile("s_waitcnt vmcnt(0)" ::: "memory");
            if (fq == 0 && fr == 0) __hip_atomic_fetch_add(pc, 1u, __ATOMIC_RELAXED, __HIP_MEMORY_SCOPE_AGENT);
            if (wc == 0) {
                unsigned spins = 0;
                while ((unsigned)__builtin_amdgcn_readfirstlane((int)__hip_atomic_load(pc, __ATOMIC_RELAXED, __HIP_MEMORY_SCOPE_AGENT)) < 16u) { __builtin_amdgcn_s_sleep(2); if (++spins > (1u << 22)) break; }
                __builtin_amdgcn_fence(__ATOMIC_ACQUIRE, "agent");
                asm volatile("s_waitcnt vmcnt(0)" ::: "memory");
            }
        }
        asm volatile("s_waitcnt vmcnt(0) lgkmcnt(0)" ::: "memory"); __builtin_amdgcn_s_barrier(); asm volatile("" ::: "memory");
#pragma unroll
        for (int ai = 0; ai < 2; ++ai)
#pragma unroll
            for (int m = 0; m < 4; ++m) {
                const int row = row0 + ai * 128 + m * 16;
                float t4[4];
#pragma unroll
                for (int t = 0; t < 4; ++t) t4[t] = __hip_atomic_load(slots + (size_t)t * M + row, __ATOMIC_RELAXED, __HIP_MEMORY_SCOPE_AGENT);
                const float rs = rsqrtf(((t4[0] + t4[1]) + (t4[2] + t4[3])) * (1.f / D) + EPS);
#pragma unroll
                for (int bj = 0; bj < 2; ++bj) {
                    const pg8::f32x4 g0 = *(const pg8::f32x4*)(gf + col0 + bj * 128), g1 = *(const pg8::f32x4*)(gf + col0 + bj * 128 + 4);
                    __builtin_nontemporal_store(acc[ai][bj][m][0] * rs * g0, (pg8::f32x4*)(out + (size_t)row * D + col0 + bj * 128));
                    __builtin_nontemporal_store(acc[ai][bj][m][1] * rs * g1, (pg8::f32x4*)(out + (size_t)row * D + col0 + bj * 128 + 4));
                }
            }
        LDS_WAIT(); __builtin_amdgcn_s_barrier(); asm volatile("" ::: "memory");
    }
};
struct EpiUp {
    static constexpr bool PERM = true, ROWPERM = true;
    bf16_t* ACT; const float* SS; const float* cw; const float* cb; float* HEAD; float* TAIL;
    __device__ __forceinline__ void operator()(pg8::f32x4 (&acc)[2][2][4][2], const pg8::Unit& u, int wr, int wc, int fr, int fq, PG8_LAS unsigned char* lds, int ui) const {
        asm volatile("" : "+v"(fr), "+v"(fq));
        const int tok0 = u.pm * 256 + (wr * 16 + fr) * 8;
        const int cbase = u.pn * 128 + wc * 32 + 8 * fq;
#pragma unroll
        for (int ai = 0; ai < 2; ++ai) {
            const pg8::f32x4 rs4 = *(PG8_LAS pg8::f32x4*)(lds + RST_OFF + (ui * 256 + (wr * 16 + fr) * 8 + ai * 4) * 4);
#pragma unroll
            for (int m = 0; m < 4; ++m)
#pragma unroll
                for (int bj = 0; bj < 2; ++bj)
#pragma unroll
                    for (int n = 0; n < 2; ++n) acc[ai][bj][m][n] *= rs4[m];
        }
        PG8_LAS float* xch = (PG8_LAS float*)(lds + XCH_OFF) + (wc * 4 + fq) * 64;
        if (fr == 15) {
            if (wr == 0) {
#pragma unroll
                for (int tk = 0; tk < 2; ++tk)
#pragma unroll
                    for (int bj = 0; bj < 2; ++bj)
#pragma unroll
                        for (int n = 0; n < 2; ++n) *(PG8_LAS pg8::f32x4*)(xch + tk * 32 + bj * 8 + n * 4) = acc[1][bj][2 + tk][n];
            } else {
#pragma unroll
                for (int tk = 0; tk < 2; ++tk)
#pragma unroll
                    for (int bj = 0; bj < 2; ++bj)
#pragma unroll
                        for (int n = 0; n < 2; ++n) *(pg8::f32x4*)(TAIL + ((size_t)u.pm * 2 + tk) * (2 * DFF) + bj * DFF + cbase + 4 * n) = acc[1][bj][2 + tk][n];
            }
        }
        if (fr == 0 && wr == 0) {
#pragma unroll
            for (int tk = 0; tk < 2; ++tk)
#pragma unroll
                for (int bj = 0; bj < 2; ++bj)
#pragma unroll
                    for (int n = 0; n < 2; ++n) *(pg8::f32x4*)(HEAD + ((size_t)u.pm * 2 + tk) * (2 * DFF) + bj * DFF + cbase + 4 * n) = acc[0][bj][tk][n];
        }
        LDS_WAIT(); __builtin_amdgcn_s_barrier(); asm volatile("" ::: "memory");
#pragma unroll
        for (int n = 0; n < 2; ++n)
#pragma unroll
            for (int bj = 0; bj < 2; ++bj) {
                const int cc = bj * DFF + cbase + 4 * n;
                const pg8::f32x4 w0 = *(const pg8::f32x4*)(cw + cc), w1 = *(const pg8::f32x4*)(cw + 2 * DFF + cc), w2 = *(const pg8::f32x4*)(cw + 4 * DFF + cc), bb = *(const pg8::f32x4*)(cb + cc);
                pg8::f32x4 p1, p2;
#pragma unroll
                for (int j = 0; j < 4; ++j) {
                    p1[j] = shfl_idx(acc[1][bj][3][n][j], fq * 16 + fr - 1);
                    p2[j] = shfl_idx(acc[1][bj][2][n][j], fq * 16 + fr - 1);
                }
                if (fr == 0) {
                    if (wr == 1) { p2 = *(PG8_LAS pg8::f32x4*)(xch + 0 * 32 + bj * 8 + n * 4); p1 = *(PG8_LAS pg8::f32x4*)(xch + 1 * 32 + bj * 8 + n * 4); }
                    else { p1 = p2 = (pg8::f32x4){0.f, 0.f, 0.f, 0.f}; }
                }
#pragma unroll
                for (int t = 7; t >= 0; --t) {
                    const pg8::f32x4 x0 = acc[t >> 2][bj][t & 3][n];
                    const pg8::f32x4 x1 = (t >= 1) ? acc[(t - 1) >> 2][bj][(t - 1) & 3][n] : p1;
                    const pg8::f32x4 x2 = (t >= 2) ? acc[(t - 2) >> 2][bj][(t - 2) & 3][n] : (t == 1 ? p1 : p2);
                    acc[t >> 2][bj][t & 3][n] = w0 * x2 + w1 * x1 + w2 * x0 + bb;
                }
                asm volatile("" ::: "memory");
            }
#pragma unroll
        for (int t = 0; t < 8; ++t) {
            if (t < 2 && fr == 0 && wr == 0) continue;
            pg8::f32x4 a, b;
#pragma unroll
            for (int j = 0; j < 4; ++j) {
                const float g0 = acc[t >> 2][0][t & 3][0][j], g1 = acc[t >> 2][0][t & 3][1][j];
                a[j] = g0 * __builtin_amdgcn_rcpf(1.f + __builtin_amdgcn_exp2f(-1.44269504f * g0)) * acc[t >> 2][1][t & 3][0][j];
                b[j] = g1 * __builtin_amdgcn_rcpf(1.f + __builtin_amdgcn_exp2f(-1.44269504f * g1)) * acc[t >> 2][1][t & 3][1][j];
            }
            u32x4 w; w.x = pk_bf16(a[0], a[1]); w.y = pk_bf16(a[2], a[3]); w.z = pk_bf16(b[0], b[1]); w.w = pk_bf16(b[2], b[3]);
            *(u32x4*)(ACT + (size_t)(tok0 + t) * DFF + cbase) = w;
        }
    }
};

__device__ __forceinline__ void transpose_item(const float* W, int ldw, int src_col0, int k0, bf16_t* WT, int K, int dst_row0, const float* gain, LAS float* scr, int lane) {
#pragma unroll
    for (int h2 = 0; h2 < 2; ++h2) { float v[16];
#pragma unroll
        for (int i = 0; i < 16; ++i) { const int kk = 2 * (16 * h2 + i) + (lane >> 5); v[i] = __builtin_nontemporal_load(W + (size_t)(k0 + kk) * ldw + src_col0 + (lane & 31));   }
#pragma unroll
        for (int i = 0; i < 16; ++i) { const int kk = 2 * (16 * h2 + i) + (lane >> 5); scr[kk * 33 + (lane & 31)] = gain ? v[i] * gain[k0 + kk] : v[i]; } }
    LDS_WAIT();
    const int c = lane & 7;
#pragma unroll
    for (int j = 0; j < 4; ++j) { const int n = (lane >> 3) + 8 * j; const LAS float* s = scr + (8 * c) * 33 + n;
        u32x4 o; o.x = pk_bf16(s[0 * 33], s[1 * 33]); o.y = pk_bf16(s[2 * 33], s[3 * 33]); o.z = pk_bf16(s[4 * 33], s[5 * 33]); o.w = pk_bf16(s[6 * 33], s[7 * 33]);
        *(u32x4*)(WT + (size_t)(dst_row0 + n) * K + k0 + 8 * c) = o; }
    LDS_WAIT();
}
__device__ __forceinline__ void convert_weights(const Params& p, int l, int mask, int gw, int NGW, LAS float* scr, int lane) {
    const int n_in = (mask & 1) ? 1024 : 0, n_out = (mask & 2) ? 512 : 0, n_up = (mask & 4) ? 2816 : 0, n_dn = (mask & 8) ? 1408 : 0;
    const int total = n_in + n_out + n_up + n_dn;
    for (int it = gw; it < total; it += NGW) {
        int r = it;
        if (r < n_in) { const int kb = r >> 6, nb = r & 63;
            transpose_item(p.in[2] + (size_t)l * D * INW, INW, 32 * nb + (nb >= 48 ? 8 : 0), 64 * kb, (bf16_t*)(p.ws + WS_WIN + (size_t)l * WS_WL1), D, 32 * nb, p.in[1] + l * D, scr, lane); continue; }
        r -= n_in;
        if (r < n_out) { const int kb = r >> 5, nb = r & 31;
            transpose_item(p.in[8] + (size_t)l * D * D, D, 32 * nb, 64 * kb, (bf16_t*)(p.ws + WS_WOUT + (size_t)l * WS_WL1), D, 32 * nb, nullptr, scr, lane); continue; }
        r -= n_out;
        if (r < n_up) { const int kb = r / 176, nb = r % 176, pn = nb >> 3, j = nb & 7; const int src = (j < 4) ? 128 * pn + 32 * j : DFF + 128 * pn + 32 * (j - 4);
            transpose_item(p.in[10] + (size_t)l * D * 2 * DFF, 2 * DFF, src, 64 * kb, (bf16_t*)(p.ws + WS_WUP + (size_t)l * WS_WL1), D, 32 * nb, p.in[9] + l * D, scr, lane); continue; }
        r -= n_up;
        { const int kb = r >> 5, nb = r & 31;
            transpose_item(p.in[13] + (size_t)l * DFF * D, D, 32 * nb, 64 * kb, (bf16_t*)(p.ws + WS_WDN + (size_t)l * WS_WL1), DFF, 32 * nb, nullptr, scr, lane); }
    }
}
__device__ __forceinline__ void gates_rows(const Params& p, int l, const float* SS, int gw, int NGW, int lane) {
    typedef short bf16x8g __attribute__((ext_vector_type(8)));
    const bf16_t* WGb = (const bf16_t*)(p.ws + WS_WG) + l * 16384; const bf16_t* XN = (const bf16_t*)(p.ws + WS_XN); float* G = (float*)(p.ws + WS_G); const float* bgt = p.in[3] + l * 8;
    const int fr = lane & 15, fq = lane >> 4;
    for (int rg = gw; rg < M / 16; rg += NGW) {
        const bf16_t* ap = XN + (size_t)(rg * 16 + fr) * D + 8 * fq; const bf16_t* bp = WGb + fr * D + 8 * fq;
        f32x4 acc = (f32x4){0.f, 0.f, 0.f, 0.f};
#pragma unroll 8
        for (int kt = 0; kt < 32; ++kt) acc = __builtin_amdgcn_mfma_f32_16x16x32_bf16(*(const bf16x8g*)(ap + 32 * kt), *(const bf16x8g*)(bp + 32 * kt), acc, 0, 0, 0);
        if (fr < 8) {
#pragma unroll
            for (int r = 0; r < 4; ++r) { const int tok = rg * 16 + 4 * fq + r; G[(size_t)tok * 8 + fr] = acc[r] * rsqrtf(ss_row(SS, tok) * (1.f / D) + EPS) + bgt[fr]; }
        }
    }
}

typedef short bf16x8v __attribute__((ext_vector_type(8)));
constexpr int PK = 72, PK2 = 136;
__device__ __forceinline__ bf16x8v ldfrag(const LAS bf16_t* base, int pitch, int row, int k0) { return *(const LAS bf16x8v*)(base + row * pitch + k0); }
__device__ __forceinline__ bf16x8v ldfrag_sw(const LAS bf16_t* base, int pitch, int row, int k0) { return *(const LAS bf16x8v*)(base + row * pitch + (k0 ^ (((row >> 3) & 7) << 3))); }
__device__ __forceinline__ bf16_t f2bf1(float x) { return (bf16_t)(pk_bf16(x, 0.f) & 0xffffu); }

__device__ __forceinline__ void conv8(const bf16_t* P, const float* wconv, int b, int c, int s, int col, float (&a)[8]) {
#pragma unroll
    for (int i = 0; i < 8; ++i) a[i] = 0.f;
#pragma unroll
    for (int j = 0; j < 4; ++j) {
        const int pos = c * CH + s - 3 + j;
        if (pos >= 0) {
            const u32x4 w = *(const u32x4*)(P + (size_t)(b * SEQ + pos) * NP + col);
            float x[8]; unpack8(w, x);
            const f32x4 c0 = *(const f32x4*)(wconv + j * 512 + col), c1 = *(const f32x4*)(wconv + j * 512 + col + 4);
            a[0] += c0[0] * x[0]; a[1] += c0[1] * x[1]; a[2] += c0[2] * x[2]; a[3] += c0[3] * x[3];
            a[4] += c1[0] * x[4]; a[5] += c1[1] * x[5]; a[6] += c1[2] * x[6]; a[7] += c1[3] * x[7];
        }
    }
#pragma unroll
    for (int i = 0; i < 8; ++i) a[i] = silu_fast(a[i]);
}
template <int NTU = 256>
__device__ __forceinline__ void load_vT(const bf16_t* P, int tok0, int h, LAS bf16_t* dst, int tid) {
    constexpr int NR = 1024 / NTU;
    u32x4 w[NR];
#pragma unroll
    for (int r = 0; r < NR; ++r) { const int id = tid + NTU * r, s = id >> 4, e8 = id & 15; w[r] = *(const u32x4*)(P + (size_t)(tok0 + s) * NP + 512 + h * DV + 8 * e8); }
#pragma unroll
    for (int r = 0; r < NR; ++r) { const int id = tid + NTU * r, s = id >> 4, e8 = id & 15;
        LAS bf16_t* d = dst + (8 * e8) * PK + (s ^ ((e8 & 7) << 3));
        d[0 * PK] = (bf16_t)(w[r].x & 0xffffu); d[1 * PK] = (bf16_t)(w[r].x >> 16); d[2 * PK] = (bf16_t)(w[r].y & 0xffffu); d[3 * PK] = (bf16_t)(w[r].y >> 16);
        d[4 * PK] = (bf16_t)(w[r].z & 0xffffu); d[5 * PK] = (bf16_t)(w[r].z >> 16); d[6 * PK] = (bf16_t)(w[r].w & 0xffffu); d[7 * PK] = (bf16_t)(w[r].w >> 16); }
}

constexpr int B1_LDS = 28672;
__device__ __forceinline__ void b1_chunk_unit(const Params& p, int l, int u, bool valid, LAS unsigned char* lds, int tid) {
    LAS bf16_t* kT = (LAS bf16_t*)lds; LAS bf16_t* vT = (LAS bf16_t*)(lds + 9216); LAS float* wl = (LAS float*)(lds + 27648);
    const bf16_t* P = (const bf16_t*)(p.ws + WS_P); const float* G = (const float*)(p.ws + WS_G);
    const int bh = u >> 6, c = u & 63, b = bh >> 2, h = bh & 3, tok0 = b * SEQ + c * CH, lane = tid & 63, w = tid >> 6, fr = lane & 15, fq = lane >> 4;
    if (tid < 64) {
        const float ig = G[(size_t)(tok0 + lane) * 8 + h], fg = G[(size_t)(tok0 + lane) * 8 + 4 + h];
        const float bc = wave_incl_sum(log_sigmoid(fg), lane);
        const float blast = shfl_idx(bc, 63);
        const float a = blast - bc + ig;
        const float mloc = wave_max(a, lane);
        wl[lane] = expf(a - mloc);
        if (lane == 0 && valid) { ((float*)(p.ws + WS_BL))[u] = blast; ((float*)(p.ws + WS_ML))[u] = mloc; }
    }
    bf16_t* QKC = (bf16_t*)(p.ws + WS_QKC);
#pragma unroll
    for (int rr = 0; rr < 4; ++rr) {
        const int id = tid + 128 * rr, s = id >> 3, dg = id & 7; float a[8];
        conv8(P, p.in[4] + l * 4 * 512, b, c, s, h * DK + 8 * dg, a);
        u32x4 o; o.x = pk_bf16(a[0], a[1]); o.y = pk_bf16(a[2], a[3]); o.z = pk_bf16(a[4], a[5]); o.w = pk_bf16(a[6], a[7]);
        if (valid) *(u32x4*)(QKC + (size_t)(tok0 + s) * 512 + h * DK + 8 * dg) = o;
    }
    __syncthreads();
#pragma unroll
    for (int rr = 0; rr < 4; ++rr) {
        const int id = tid + 128 * rr, s = id >> 3, dg = id & 7; float a[8];
        conv8(P, p.in[4] + l * 4 * 512, b, c, s, 256 + h * DK + 8 * dg, a);
#pragma unroll
        for (int i = 0; i < 8; ++i) a[i] *= 0.125f;
        u32x4 o; o.x = pk_bf16(a[0], a[1]); o.y = pk_bf16(a[2], a[3]); o.z = pk_bf16(a[4], a[5]); o.w = pk_bf16(a[6], a[7]);
        if (valid) *(u32x4*)(QKC + (size_t)(tok0 + s) * 512 + 256 + h * DK + 8 * dg) = o;
        const float ws_ = wl[s];
#pragma unroll
        for (int i = 0; i < 8; ++i) kT[(8 * dg + i) * PK + (s ^ (dg << 3))] = f2bf1(a[i] * ws_);
    }
    load_vT<128>(P, tok0, h, vT, tid);
    __syncthreads();
    bf16_t* CST = (bf16_t*)(p.ws + WS_CST) + (size_t)u * 8192;
#pragma unroll
    for (int e2 = 0; e2 < 4; ++e2) {
        const int et = 4 * w + e2;
        f32x4 acc[4];
#pragma unroll
        for (int i = 0; i < 4; ++i) acc[i] = (f32x4){0.f, 0.f, 0.f, 0.f};
#pragma unroll
        for (int kt = 0; kt < 2; ++kt) {
            const bf16x8v bf = ldfrag_sw(vT, PK, 16 * et + fr, 32 * kt + 8 * fq);
#pragma unroll
            for (int mt = 0; mt < 4; ++mt) acc[mt] = __builtin_amdgcn_mfma_f32_16x16x32_bf16(ldfrag_sw(kT, PK, 16 * mt + fr, 32 * kt + 8 * fq), bf, acc[mt], 0, 0, 0);
        }
        if (valid) {
#pragma unroll
            for (int mt = 0; mt < 4; ++mt) { u32x2 o; o.x = pk_bf16(acc[mt][0], acc[mt][1]); o.y = pk_bf16(acc[mt][2], acc[mt][3]); *(u32x2*)(CST + (16 * et + fr) * 64 + 16 * mt + 4 * fq) = o; }
        }
    }
    if (tid < 64) { float s = 0.f;
#pragma unroll
        for (int i = 0; i < 8; ++i) { const u32x4 q = *(const LAS u32x4*)(kT + tid * PK + 8 * i); float x[8]; unpack8(q, x); s += ((x[0] + x[1]) + (x[2] + x[3])) + ((x[4] + x[5]) + (x[6] + x[7])); }
        if (valid) ((float*)(p.ws + WS_NST))[(size_t)u * 64 + tid] = s; }
    __syncthreads();
}
template <int W>
__device__ __forceinline__ void pool_dm(const bf16_t* P, int tok0, int pos0, int g, LAS bf16_t* dm, int tid) {
    const int tg = tid >> 4, c8 = tid & 15, t0 = 8 * tg;
    const bf16_t* src = P + (size_t)(tok0 + t0) * NP + 1536 + g * 128 + 8 * c8;
    u32x4 raw[W + 7];
#pragma unroll
    for (int i = 0; i < W + 7; ++i) { const int rel = i - (W - 1); raw[i] = (pos0 + t0 + rel >= 0) ? *(const u32x4*)(src + (long)rel * NP) : (u32x4){0u, 0u, 0u, 0u}; }
    float sum[8];
#pragma unroll
    for (int k = 0; k < 8; ++k) sum[k] = 0.f;
#pragma unroll
    for (int i = 0; i < W - 1; ++i) { float x[8]; unpack8(raw[i], x);
#pragma unroll
        for (int k = 0; k < 8; ++k) sum[k] += x[k]; }
#pragma unroll
    for (int tt = 0; tt < 8; ++tt) {
        float cur[8]; unpack8(raw[tt + W - 1], cur);
#pragma unroll
        for (int k = 0; k < 8; ++k) sum[k] += cur[k];
        const int cnt = min(pos0 + t0 + tt + 1, W);
        const float inv = 1.f / (float)cnt;
        float o[8];
#pragma unroll
        for (int k = 0; k < 8; ++k) o[k] = sum[k] * inv - cur[k];
        u32x4 ov; ov.x = pk_bf16(o[0], o[1]); ov.y = pk_bf16(o[2], o[3]); ov.z = pk_bf16(o[4], o[5]); ov.w = pk_bf16(o[6], o[7]);
        *(LAS u32x4*)(dm + (t0 + tt) * PK2 + 8 * c8) = ov;
        float old[8]; unpack8(raw[tt], old);
#pragma unroll
        for (int k = 0; k < 8; ++k) sum[k] -= old[k];
    }
}
__device__ __forceinline__ void pool_unit(const Params& p, int l, int pu, LAS unsigned char* lds, int tid) {
    LAS bf16_t* wT = (LAS bf16_t*)lds; LAS bf16_t* dm = (LAS bf16_t*)(lds + 34816);
    const bf16_t* P = (const bf16_t*)(p.ws + WS_P); bf16_t* HC = (bf16_t*)(p.ws + WS_HCAT);
    const int tb = pu >> 2, g = pu & 3, tok0 = tb * 256, pos0 = tok0 & (SEQ - 1), lane = tid & 63, w = tid >> 6, fr = lane & 15, fq = lane >> 4;
    const bf16_t* wsrc = (const bf16_t*)(p.ws + WS_WPT) + ((size_t)l * 4 + g) * 128 * 128;
#pragma unroll
    for (int r = 0; r < 4; ++r) { const int id = tid + 512 * r, dc = id >> 4, c8 = id & 15; *(LAS u32x4*)(wT + dc * PK2 + 8 * c8) = *(const u32x4*)(wsrc + dc * 128 + 8 * c8); }
    if (g == 0) pool_dm<2>(P, tok0, pos0, g, dm, tid); else if (g == 1) pool_dm<4>(P, tok0, pos0, g, dm, tid); else if (g == 2) pool_dm<8>(P, tok0, pos0, g, dm, tid); else pool_dm<16>(P, tok0, pos0, g, dm, tid);
    __syncthreads();
    bf16x8v af[4];
#pragma unroll
    for (int kt = 0; kt < 4; ++kt) af[kt] = ldfrag(wT, PK2, 16 * w + fr, 32 * kt + 8 * fq);
    const f32x4 ps = *(const f32x4*)(p.in[7] + l * 512 + g * 128 + 16 * w + 4 * fq);
#pragma unroll 4
    for (int nt = 0; nt < 16; ++nt) {
        f32x4 acc = (f32x4){0.f, 0.f, 0.f, 0.f};
#pragma unroll
        for (int kt = 0; kt < 4; ++kt) acc = __builtin_amdgcn_mfma_f32_16x16x32_bf16(af[kt], ldfrag(dm, PK2, 16 * nt + fr, 32 * kt + 8 * fq), acc, 0, 0, 0);
        const f32x4 y = acc * ps; u32x2 o; o.x = pk_bf16(y[0], y[1]); o.y = pk_bf16(y[2], y[3]);
        *(u32x2*)(HC + (size_t)(tok0 + 16 * nt + fr) * D + 512 + g * 128 + 16 * w + 4 * fq) = o;
    }
    __syncthreads();
}
__device__ __forceinline__ void b2_scan_pool(const Params& p, int l, LAS unsigned char* lds, int bx, int G_, int tid) {
    const int grp = tid >> 8, tl = tid & 255, lane = tid & 63, w = tl >> 6, fr = lane & 15, fq = lane >> 4;
    LAS bf16_t* wT = (LAS bf16_t*)lds; LAS bf16_t* dm = (LAS bf16_t*)(lds + 34816);
    LAS float* s_sp = (LAS float*)(lds + 104448); LAS float* s_sl = s_sp + 64;
    const float* BL = (const float*)(p.ws + WS_BL); const float* ML = (const float*)(p.ws + WS_ML); float* MP = (float*)(p.ws + WS_MP);
    const bf16_t* P = (const bf16_t*)(p.ws + WS_P); bf16_t* HC = (bf16_t*)(p.ws + WS_HCAT);
    for (int it = bx; it < 256; it += G_) {
        unsigned cl[64];
        if (grp == 0) {
            int it0 = it; asm volatile("" : "+s"(it0)); const int bh = it0 >> 4, sub = it0 & 15;
            { const unsigned* q = (const unsigned*)((const bf16_t*)(p.ws + WS_CST) + (size_t)bh * 64 * 8192 + sub * 512 + 2 * tl);
              int stride0 = 4096; asm volatile("" : "+v"(stride0));
#pragma unroll
              for (int c = 0; c < 64; ++c) { cl[c] = __builtin_nontemporal_load(q); q += stride0; } }
            if (tl < 64) {
                const float gg = BL[bh * 64 + lane], ml = ML[bh * 64 + lane];
                float m = 0.f, mp = 0.f, mn_own = 0.f;
                for (int c = 0; c < 64; ++c) {
                    const float gc = __builtin_bit_cast(float, __builtin_amdgcn_readlane(__builtin_bit_cast(int, gg), c)), mlc = __builtin_bit_cast(float, __builtin_amdgcn_readlane(__builtin_bit_cast(int, ml), c));
                    const float mn = fmaxf(gc + m, mlc);
                    if (lane == c) { mp = m; mn_own = mn; }
                    m = mn;
                }
                s_sp[lane] = expf(gg + mp - mn_own); s_sl[lane] = expf(ml - mn_own);
                if (sub == 0) MP[bh * 64 + lane] = mp;
            }
        } else {
            int it1 = it; asm volatile("" : "+s"(it1)); const int tb = it1 >> 2, g = it1 & 3, tok0 = tb * 256, pos0 = tok0 & (SEQ - 1);
            const bf16_t* wsrc = (const bf16_t*)(p.ws + WS_WPT) + ((size_t)l * 4 + g) * 128 * 128;
#pragma unroll
            for (int r = 0; r < 8; ++r) { const int id = tl + 256 * r, dc = id >> 4, c8 = id & 15; *(LAS u32x4*)(wT + dc * PK2 + 8 * c8) = *(const u32x4*)(wsrc + dc * 128 + 8 * c8); }
#pragma unroll 1
            for (int r = 0; r < 2; ++r) { const int id = tl + 256 * r;
                if (g == 0) pool_dm<2>(P, tok0, pos0, g, dm, id); else if (g == 1) pool_dm<4>(P, tok0, pos0, g, dm, id); else if (g == 2) pool_dm<8>(P, tok0, pos0, g, dm, id); else pool_dm<16>(P, tok0, pos0, g, dm, id); }
        }
        __syncthreads();
        if (grp == 0) {
            int it0 = it; asm volatile("" : "+s"(it0)); const int bh = it0 >> 4, sub = it0 & 15;
            const LAS float* vsp = s_sp; const LAS float* vsl = s_sl; asm volatile("" : "+v"(vsp), "+v"(vsl));
            {
                const size_t off = (size_t)bh * 64 * 8192 + sub * 512 + 2 * tl;
                const unsigned* base = (const unsigned*)((const bf16_t*)(p.ws + WS_CST) + off); unsigned* ob = (unsigned*)((bf16_t*)(p.ws + WS_CPB) + off);
                int stride = 4096; asm volatile("" : "+v"(stride));
                float c0 = 0.f, c1 = 0.f;
                { unsigned* q = ob;
#pragma unroll
                  for (int c = 0; c < 64; ++c) { *q = pk_bf16(c0, c1); q += stride; const float sp = vsp[c], sl = vsl[c]; c0 = sp * c0 + sl * bf_lo(cl[c]); c1 = sp * c1 + sl * bf_hi(cl[c]); } }
            }
            if (sub == 0 && tl < 64) {
                float* base = (float*)(p.ws + WS_NST) + (size_t)bh * 64 * 64 + tl;
                float cl[64];
#pragma unroll
                for (int c = 0; c < 64; ++c) cl[c] = base[c * 64];
                float cs = 0.f;
#pragma unroll
                for (int c = 0; c < 64; ++c) { base[c * 64] = cs; cs = vsp[c] * cs + vsl[c] * cl[c]; }
            }
        } else {
            int it1 = it; asm volatile("" : "+s"(it1)); const int tb = it1 >> 2, g = it1 & 3, tok0 = tb * 256;
            bf16x8v af[2][4];
#pragma unroll
            for (int d2 = 0; d2 < 2; ++d2)
#pragma unroll
                for (int kt = 0; kt < 4; ++kt) af[d2][kt] = ldfrag(wT, PK2, 32 * w + 16 * d2 + fr, 32 * kt + 8 * fq);
            f32x4 ps[2];
#pragma unroll
            for (int d2 = 0; d2 < 2; ++d2) ps[d2] = *(const f32x4*)(p.in[7] + l * 512 + g * 128 + 32 * w + 16 * d2 + 4 * fq);
#pragma unroll 2
            for (int nt = 0; nt < 16; ++nt) {
                bf16x8v bd[4];
#pragma unroll
                for (int kt = 0; kt < 4; ++kt) bd[kt] = ldfrag(dm, PK2, 16 * nt + fr, 32 * kt + 8 * fq);
#pragma unroll
                for (int d2 = 0; d2 < 2; ++d2) {
                    f32x4 acc = (f32x4){0.f, 0.f, 0.f, 0.f};
#pragma unroll
                    for (int kt = 0; kt < 4; ++kt) acc = __builtin_amdgcn_mfma_f32_16x16x32_bf16(af[d2][kt], bd[kt], acc, 0, 0, 0);
                    const f32x4 y = acc * ps[d2]; u32x2 o; o.x = pk_bf16(y[0], y[1]); o.y = pk_bf16(y[2], y[3]);
                    *(u32x2*)(HC + (size_t)(tok0 + 16 * nt + fr) * D + 512 + g * 128 + 32 * w + 16 * d2 + 4 * fq) = o;
                }
            }
        }
        __syncthreads();
    }
}
constexpr int B3_LDS = 68608;
__device__ __forceinline__ void b3_chunk_unit(const Params& p, int l, int u, bool valid, LAS unsigned char* lds, int tid) {
    LAS bf16_t* qs = (LAS bf16_t*)lds; LAS bf16_t* ks = (LAS bf16_t*)(lds + 9216); LAS bf16_t* vT = (LAS bf16_t*)(lds + 18432); LAS bf16_t* cpT = (LAS bf16_t*)(lds + 36864);
    LAS bf16_t* Sb = (LAS bf16_t*)(lds + 55296); LAS float* sca = (LAS float*)(lds + 64512); LAS float* part = (LAS float*)(lds + 66048);
    LAS float* s_u = sca, * s_bm = sca + 64, * s_m = sca + 128, * s_sc = sca + 192, * s_np = sca + 256, * s_den = sca + 320;
    const bf16_t* P = (const bf16_t*)(p.ws + WS_P); const float* G = (const float*)(p.ws + WS_G); bf16_t* HC = (bf16_t*)(p.ws + WS_HCAT);
    const int bh = u >> 6, c = u & 63, b = bh >> 2, h = bh & 3, tok0 = b * SEQ + c * CH, lane = tid & 63, w = tid >> 6, fr = lane & 15, fq = lane >> 4;
    u32x2 ow[2][4]; f32x4 gh[2];
#pragma unroll
    for (int e2 = 0; e2 < 2; ++e2) { gh[e2] = *(const f32x4*)(p.in[5] + l * 512 + h * DV + 32 * w + 16 * e2 + 4 * fq);
#pragma unroll
        for (int nt = 0; nt < 4; ++nt) ow[e2][nt] = __builtin_nontemporal_load((const u32x2*)(P + (size_t)(tok0 + 16 * nt + fr) * NP + 1024 + h * DV + 32 * w + 16 * e2 + 4 * fq)); }
    if (tid < 64) {
        const float ig = G[(size_t)(tok0 + lane) * 8 + h], fg = G[(size_t)(tok0 + lane) * 8 + 4 + h];
        const float bc = wave_incl_sum(log_sigmoid(fg), lane);
        const float uu = ig - bc;
        const float pm = wave_incl_max(uu, lane);
        const float mprev = ((const float*)(p.ws + WS_MP))[u];
        const float minter = bc + mprev;
        const float mm = fmaxf(minter, bc + pm);
        s_u[lane] = uu; s_bm[lane] = bc - mm; s_m[lane] = mm; s_sc[lane] = expf(minter - mm);
        s_np[lane] = ((const float*)(p.ws + WS_NST))[(size_t)u * 64 + lane];
    }
    { const bf16_t* CPB = (const bf16_t*)(p.ws + WS_CPB) + (size_t)u * 8192;
      u32x4 t[4];
#pragma unroll
      for (int r = 0; r < 4; ++r) { const int id = tid + 256 * r, e = id >> 3, d8 = id & 7; t[r] = __builtin_nontemporal_load((const u32x4*)(CPB + e * 64 + 8 * d8)); }
#pragma unroll
      for (int r = 0; r < 4; ++r) { const int id = tid + 256 * r, e = id >> 3, d8 = id & 7; *(LAS u32x4*)(cpT + e * PK + 8 * d8) = t[r]; } }
    load_vT(P, tok0, h, vT, tid);
    { const bf16_t* QKC = (const bf16_t*)(p.ws + WS_QKC); u32x4 tq[2], tk[2];
#pragma unroll
      for (int rr = 0; rr < 2; ++rr) { const int id = tid + 256 * rr, s = id >> 3, dg = id & 7;
          tq[rr] = __builtin_nontemporal_load((const u32x4*)(QKC + (size_t)(tok0 + s) * 512 + h * DK + 8 * dg)); tk[rr] = __builtin_nontemporal_load((const u32x4*)(QKC + (size_t)(tok0 + s) * 512 + 256 + h * DK + 8 * dg)); }
#pragma unroll
      for (int rr = 0; rr < 2; ++rr) { const int id = tid + 256 * rr, s = id >> 3, dg = id & 7;
          *(LAS u32x4*)(qs + s * PK + 8 * dg) = tq[rr]; *(LAS u32x4*)(ks + s * PK + 8 * dg) = tk[rr]; } }
    __syncthreads();
    {
        const int mt = w;
#pragma unroll
        for (int nt = 0; nt < 4; ++nt) {
            f32x4 acc = (f32x4){0.f, 0.f, 0.f, 0.f};
            if (mt <= nt) {
#pragma unroll
                for (int kt = 0; kt < 2; ++kt) acc = __builtin_amdgcn_mfma_f32_16x16x32_bf16(ldfrag(ks, PK, 16 * mt + fr, 32 * kt + 8 * fq), ldfrag(qs, PK, 16 * nt + fr, 32 * kt + 8 * fq), acc, 0, 0, 0);
            }
            const int j = 16 * nt + fr; const float bm = s_bm[j]; float o[4];
#pragma unroll
            for (int r = 0; r < 4; ++r) { const int s = 16 * mt + 4 * fq + r; o[r] = (s <= j) ? acc[r] * exp_fast(bm + s_u[s]) : 0.f; }
            u32x2 ov; ov.x = pk_bf16(o[0], o[1]); ov.y = pk_bf16(o[2], o[3]);
            *(LAS u32x2*)(Sb + j * PK + 16 * mt + 4 * fq) = ov;
        }
    }
    __syncthreads();
    if (tid < 64) {
        float s1 = 0.f, s2 = 0.f;
#pragma unroll
        for (int i = 0; i < 8; ++i) { const u32x4 a = *(const LAS u32x4*)(Sb + tid * PK + 8 * i), qv = *(const LAS u32x4*)(qs + tid * PK + 8 * i); float x[8], y[8]; unpack8(a, x); unpack8(qv, y);
#pragma unroll
            for (int k = 0; k < 8; ++k) { s1 += x[k]; s2 += y[k] * s_np[8 * i + k]; } }
        s_den[tid] = s1 + s_sc[tid] * s2;
    }
    f32x4 a1[2][4], a2[2][4];
#pragma unroll
    for (int e2 = 0; e2 < 2; ++e2)
#pragma unroll
        for (int nt = 0; nt < 4; ++nt) { a1[e2][nt] = (f32x4){0.f, 0.f, 0.f, 0.f}; a2[e2][nt] = (f32x4){0.f, 0.f, 0.f, 0.f}; }
#pragma unroll
    for (int kt = 0; kt < 2; ++kt) {
        bf16x8v bs[4], bq[4];
#pragma unroll
        for (int nt = 0; nt < 4; ++nt) { bs[nt] = ldfrag(Sb, PK, 16 * nt + fr, 32 * kt + 8 * fq); bq[nt] = ldfrag(qs, PK, 16 * nt + fr, 32 * kt + 8 * fq); }
#pragma unroll
        for (int e2 = 0; e2 < 2; ++e2) {
            const bf16x8v av = ldfrag_sw(vT, PK, 32 * w + 16 * e2 + fr, 32 * kt + 8 * fq), ac = ldfrag(cpT, PK, 32 * w + 16 * e2 + fr, 32 * kt + 8 * fq);
#pragma unroll
            for (int nt = 0; nt < 4; ++nt) {
                a1[e2][nt] = __builtin_amdgcn_mfma_f32_16x16x32_bf16(av, bs[nt], a1[e2][nt], 0, 0, 0);
                a2[e2][nt] = __builtin_amdgcn_mfma_f32_16x16x32_bf16(ac, bq[nt], a2[e2][nt], 0, 0, 0);
            }
        }
    }
    __syncthreads();
#pragma unroll
    for (int nt = 0; nt < 4; ++nt) {
        const int j = 16 * nt + fr; const float sc = s_sc[j];
        const float dn = __builtin_amdgcn_rcpf(fmaxf(fabsf(s_den[j]), exp_fast(-s_m[j])));
        float ssq = 0.f;
#pragma unroll
        for (int e2 = 0; e2 < 2; ++e2) { a1[e2][nt] = (a1[e2][nt] + sc * a2[e2][nt]) * dn;
            ssq += (a1[e2][nt][0] * a1[e2][nt][0] + a1[e2][nt][1] * a1[e2][nt][1]) + (a1[e2][nt][2] * a1[e2][nt][2] + a1[e2][nt][3] * a1[e2][nt][3]); }
        ssq += shfl_idx(ssq, lane ^ 16); ssq += shfl_idx(ssq, lane ^ 32);
        if (fq == 0) part[w * 64 + j] = ssq;
    }
    __syncthreads();
#pragma unroll
    for (int nt = 0; nt < 4; ++nt) {
        const int j = 16 * nt + fr;
        const float tot = (part[j] + part[64 + j]) + (part[128 + j] + part[192 + j]);
        const float rn = rsqrtf(tot * (1.f / DV) + EPS);
#pragma unroll
        for (int e2 = 0; e2 < 2; ++e2) {
            const f32x4 hv = a1[e2][nt]; const u32x2 o = ow[e2][nt]; const f32x4 g4 = gh[e2];
            const f32x4 y = (f32x4){hv[0] * rn * g4[0] * sigmoid_fast(bf_lo(o.x)), hv[1] * rn * g4[1] * sigmoid_fast(bf_hi(o.x)), hv[2] * rn * g4[2] * sigmoid_fast(bf_lo(o.y)), hv[3] * rn * g4[3] * sigmoid_fast(bf_hi(o.y))};
            u32x2 o2; o2.x = pk_bf16(y[0], y[1]); o2.y = pk_bf16(y[2], y[3]);
            if (valid) *(u32x2*)(HC + (size_t)(tok0 + j) * D + h * DV + 32 * w + 16 * e2 + 4 * fq) = o2;
        }
    }
    __syncthreads();
}
__device__ __forceinline__ void ffn_fixup_tile(const Params& p, int l, int pm, int tid) {
    const float* HEAD = (const float*)(p.ws + WS_HEAD); const float* TAIL = (const float*)(p.ws + WS_TAIL); bf16_t* ACT = (bf16_t*)(p.ws + WS_ACT);
    const float* cw = p.in[11] + (size_t)l * 3 * 2 * DFF; const float* cb = p.in[12] + (size_t)l * 2 * DFF;
    const bool first = (pm & 15) == 0;
    for (int id = tid; id < 2 * (DFF / 4); id += NT) {
        const int t = id / (DFF / 4), c = 4 * (id % (DFF / 4));
        f32x4 o[2];
#pragma unroll
        for (int gv = 0; gv < 2; ++gv) {
            const int cc = gv * DFF + c; const f32x4 z = (f32x4){0.f, 0.f, 0.f, 0.f};
            const f32x4 t0 = first ? z : *(const f32x4*)(TAIL + ((size_t)(pm - 1) * 2 + 0) * (2 * DFF) + cc), t1 = first ? z : *(const f32x4*)(TAIL + ((size_t)(pm - 1) * 2 + 1) * (2 * DFF) + cc);
            const f32x4 h0 = *(const f32x4*)(HEAD + ((size_t)pm * 2 + 0) * (2 * DFF) + cc), h1 = *(const f32x4*)(HEAD + ((size_t)pm * 2 + 1) * (2 * DFF) + cc);
            const f32x4 x2 = t ? t1 : t0, x1 = t ? h0 : t1, x0 = t ? h1 : h0;
            o[gv] = *(const f32x4*)(cw + cc) * x2 + *(const f32x4*)(cw + 2 * DFF + cc) * x1 + *(const f32x4*)(cw + 4 * DFF + cc) * x0 + *(const f32x4*)(cb + cc);
        }
        u32x2 w; w.x = pk_bf16(silu_fast(o[0][0]) * o[1][0], silu_fast(o[0][1]) * o[1][1]); w.y = pk_bf16(silu_fast(o[0][2]) * o[1][2], silu_fast(o[0][3]) * o[1][3]);
        *(u32x2*)(ACT + (size_t)(pm * 256 + t) * DFF + c) = w;
    }
}
__device__ __forceinline__ void ffn_fixup(const Params& p, int l, int gt, int GT) {
    const float* HEAD = (const float*)(p.ws + WS_HEAD); const float* TAIL = (const float*)(p.ws + WS_TAIL); bf16_t* ACT = (bf16_t*)(p.ws + WS_ACT);
    const float* cw = p.in[11] + (size_t)l * 3 * 2 * DFF; const float* cb = p.in[12] + (size_t)l * 2 * DFF;
    for (int i = gt; i < 64 * 2 * DFF; i += GT) {
        const int pm = i / (2 * DFF), r = i % (2 * DFF), t = r / DFF, c = r % DFF;
        float o[2];
#pragma unroll
        for (int gv = 0; gv < 2; ++gv) {
            const int cc = gv * DFF + c;
            const bool first = (pm & 15) == 0;
            const float t0 = first ? 0.f : TAIL[((size_t)(pm - 1) * 2 + 0) * (2 * DFF) + cc], t1 = first ? 0.f : TAIL[((size_t)(pm - 1) * 2 + 1) * (2 * DFF) + cc];
            const float h0 = HEAD[((size_t)pm * 2 + 0) * (2 * DFF) + cc], h1 = HEAD[((size_t)pm * 2 + 1) * (2 * DFF) + cc];
            const float x2 = t ? t1 : t0, x1 = t ? h0 : t1, x0 = t ? h1 : h0;
            o[gv] = cw[cc] * x2 + cw[2 * DFF + cc] * x1 + cw[4 * DFF + cc] * x0 + cb[cc];
        }
        const float a = silu_f(o[0]) * o[1];
        ACT[(size_t)(pm * 256 + t) * DFF + c] = (bf16_t)(pk_bf16(a, 0.f) & 0xffffu);
    }
}

#define XB_TMO      128
#define XB_XCNT(j)  (256  + 64 * (j))
#define XB_XSUB(j)  (1280 + 64 * (j))
#define XB_XGEN(j)  (2304 + 64 * (j))
#define XB_TOP      3328
#define XB_TOPGEN   3392
#define XCD_BAR_WORDS 3456
#define XB_SPIN_CAP (1u << 18)

__device__ __forceinline__ unsigned xb_ld(unsigned* p)              { return __hip_atomic_load(p, __ATOMIC_RELAXED, __HIP_MEMORY_SCOPE_AGENT); }
__device__ __forceinline__ unsigned xb_add(unsigned* p, unsigned v) { return __hip_atomic_fetch_add(p, v, __ATOMIC_RELAXED, __HIP_MEMORY_SCOPE_AGENT); }
__device__ __forceinline__ unsigned xb_xcc_id() { return (unsigned)__builtin_amdgcn_s_getreg((3 << 11) | 20) & 0xFu; }
#define XB_SPIN(cond, bar) do { unsigned _sp = 0; while (cond) { __builtin_amdgcn_s_sleep(1); \
    if ((++_sp & 255u) == 0u) { if (xb_ld(&(bar)[XB_TMO])) break; if (_sp > XB_SPIN_CAP) { atomicAdd(&(bar)[XB_TMO], 1u); break; } } } } while (0)

struct XcdBarrier {
    unsigned* bar; unsigned x;
    volatile LAS unsigned* st;
};

__device__ __forceinline__ XcdBarrier xcd_barrier_post(unsigned* bar, volatile LAS unsigned* st) {
    XcdBarrier b; b.bar = bar; b.x = xb_xcc_id(); b.st = st;
    if (threadIdx.x == 0) (void)xb_add(&bar[XB_XCNT(b.x)], 1u);
    return b;
}
__device__ __forceinline__ void xcd_barrier_complete(unsigned* bar, unsigned x, unsigned& nloc, unsigned& nx) {
    const unsigned G = gridDim.x * gridDim.y * gridDim.z;
    unsigned sum, cnt, mine, sp = 0u;
    for (;;) {
        sum = 0u; cnt = 0u; mine = 0u;
#pragma unroll
        for (unsigned j = 0; j < 16; ++j) { const unsigned c = xb_ld(&bar[XB_XCNT(j)]); sum += c; cnt += (c > 0u) ? 1u : 0u; mine = (j == x) ? c : mine; }
        if (sum == G) break;
        __builtin_amdgcn_s_sleep(1);
        if ((++sp & 255u) == 0u) { if (xb_ld(&bar[XB_TMO])) break; if (sp > XB_SPIN_CAP) { atomicAdd(&bar[XB_TMO], 1u); break; } }
    }
    nloc = mine > 0u ? mine : 1u; nx = cnt > 0u ? cnt : 1u;
}

__device__ __forceinline__ void xcd_barrier(const XcdBarrier& b, int wave0) {
    int l0_; asm volatile("v_mbcnt_lo_u32_b32 %0, -1, 0\n\tv_mbcnt_hi_u32_b32 %0, -1, %0" : "=v"(l0_));
    const bool leader_ = (wave0 == 0) && (l0_ == 0);
    asm volatile("s_waitcnt vmcnt(0)" ::: "memory");
    __syncthreads();
    if (leader_) {
        unsigned* bar = b.bar;
        __builtin_amdgcn_s_waitcnt(0);
        unsigned nloc = b.st[0], nx = b.st[1];
        if (nloc == 0u) { xcd_barrier_complete(bar, b.x, nloc, nx); b.st[0] = nloc; b.st[1] = nx; }
        const unsigned old = xb_add(&bar[XB_XSUB(b.x)], 1u);
        const unsigned gen = old / nloc;
        if (old + 1u == (gen + 1u) * nloc) {
            __builtin_amdgcn_fence(__ATOMIC_RELEASE, "agent");
            asm volatile("s_waitcnt vmcnt(0)" ::: "memory");
            const unsigned og = xb_add(&bar[XB_TOP], 1u);
            const unsigned tg = og / nx;
            if (og + 1u == (tg + 1u) * nx) xb_add(&bar[XB_TOPGEN], 1u);
            else XB_SPIN(xb_ld(&bar[XB_TOPGEN]) == tg, bar);
            __builtin_amdgcn_fence(__ATOMIC_ACQUIRE, "agent");
            xb_add(&bar[XB_XGEN(b.x)], 1u);
            asm volatile("s_waitcnt vmcnt(0)" ::: "memory");
        } else {
            XB_SPIN(xb_ld(&bar[XB_XGEN(b.x)]) == gen, bar);
            __builtin_amdgcn_fence(__ATOMIC_ACQUIRE, "agent");
            asm volatile("s_waitcnt vmcnt(0)" ::: "memory");
        }
    }
    __syncthreads();
}


typedef const __attribute__((address_space(4))) Params* KernargP;
#define PHASE_BEGIN() KernargP kp_ = (KernargP)__builtin_amdgcn_kernarg_segment_ptr(); asm volatile("" : "+s"(kp_)); const Params& p = *(const Params*)kp_; \
    int lane_; asm volatile("v_mbcnt_lo_u32_b32 %0, -1, 0\n\tv_mbcnt_hi_u32_b32 %0, -1, %0" : "=v"(lane_)); const int wave_ = wave0; const int tid_ = wave_ * 64 + lane_; \
    const int G_ = gridDim.x, bx = blockIdx.x; const int gw_ = bx * NWAVES + wave_, NGW = G_ * NWAVES, gt_ = bx * NT + tid_, GT = G_ * NT; \
    LAS float* scr_ = (LAS float*)(lds + wave_ * 16384); float* SSb = (float*)(p.ws + WS_SS); bf16_t* XN = (bf16_t*)(p.ws + WS_XN); \
    (void)lane_; (void)gw_; (void)NGW; (void)gt_; (void)GT; (void)scr_; (void)SSb; (void)XN;
#define GRID_BAR() do { KernargP kb_ = (KernargP)__builtin_amdgcn_kernarg_segment_ptr(); asm volatile("" : "+s"(kb_)); XcdBarrier b_; b_.bar = (unsigned*)(((const Params*)kb_)->ws + WS_CTL); b_.x = xb_xcc_id(); \
    b_.st = (volatile LAS unsigned*)(lds + MISC_OFF); xcd_barrier(b_, wave0); } while (0)
template <int l>
__device__ __forceinline__ void layer_body(LAS unsigned char* lds, const int wave0) {
        { PHASE_BEGIN(); const float* SSmix = SSb + (size_t)(2 * l) * 4 * M;
          { pg8::Gemm g{XN, (const bf16_t*)(p.ws + WS_WIN + (size_t)l * WS_WL1), M, NP, D}; pg8::StaticOrder S; S.init(M, NP, G_, bx);
            EpiIn E{(bf16_t*)(p.ws + WS_P), SSmix};
            pg8::gemm_phase<EpiIn, pg8::StaticOrder, false, true>(lds, g, S, E, tid_); }
        }
        { PHASE_BEGIN(); gates_rows(p, l, SSb + (size_t)(2 * l) * 4 * M, gw_, NGW, lane_); }
        GRID_BAR();
        { PHASE_BEGIN(); const int grp = wave_ >> 1, tl = tid_ & 127;
          for (int i = 0; ; ++i) { if (bx + 4 * i * G_ >= NUNIT) break; int u = bx + (4 * i + grp) * G_; const bool valid = u < NUNIT; if (!valid) u = NUNIT - 1;
              b1_chunk_unit(p, l, u, valid, lds + grp * B1_LDS, tl); }
        }
        GRID_BAR();
        { PHASE_BEGIN(); b2_scan_pool(p, l, lds, bx, G_, tid_); }
        GRID_BAR();
        { PHASE_BEGIN(); const int grp = wave_ >> 2, tl = tid_ & 255;
          for (int i = 0; ; ++i) { if (bx + 2 * i * G_ >= NUNIT) break; int u = bx + (2 * i + grp) * G_; const bool valid = u < NUNIT; if (!valid) u = NUNIT - 1;
              b3_chunk_unit(p, l, u, valid, lds + grp * B3_LDS, tl); } }
        GRID_BAR();
        { PHASE_BEGIN();
          pg8::Gemm g{(const bf16_t*)(p.ws + WS_HCAT), (const bf16_t*)(p.ws + WS_WOUT + (size_t)l * WS_WL1), M, D, D}; pg8::StaticOrder S; S.init(M, D, G_, bx);
          EpiRes E{XN, SSb + (size_t)(2 * l + 1) * 4 * M};
          pg8::gemm_phase<EpiRes, pg8::StaticOrder, true, true>(lds, g, S, E, tid_); }
        GRID_BAR();
        { PHASE_BEGIN();
          pg8::Gemm g{XN, (const bf16_t*)(p.ws + WS_WUP + (size_t)l * WS_WL1), M, 2 * DFF, D}; pg8::StaticOrder S; S.init(M, 2 * DFF, G_, bx, 4);
          { const float* SSn = SSb + (size_t)(2 * l + 1) * 4 * M; LAS float* rsT = (LAS float*)(lds + RST_OFF);
            for (int i = 0; i < 6; ++i) { pg8::Unit uu; if (!S.next(i, uu)) break; if (tid_ < 256) rsT[i * 256 + tid_] = rsqrtf(ss_row(SSn, uu.pm * 256 + tid_) * (1.f / D) + EPS); }
            __syncthreads(); }
          EpiUp E{(bf16_t*)(p.ws + WS_ACT), SSb + (size_t)(2 * l + 1) * 4 * M, p.in[11] + (size_t)l * 3 * 2 * DFF, p.in[12] + (size_t)l * 2 * DFF, (float*)(p.ws + WS_HEAD), (float*)(p.ws + WS_TAIL)};
          pg8::gemm_phase<EpiUp, pg8::StaticOrder, true, true>(lds, g, S, E, tid_);
          { const int NU = 64 * 22, nmax = (NU + G_ - 1) / G_, b0 = NU - (nmax - 1) * G_;
            int ib = bx - b0, nb = G_ - b0; if (nb <= 0) { ib = bx; nb = G_; }
            if (ib >= 0) { const int cgw = ib * NWAVES + wave_, cng = nb * NWAVES;
                if (l == 0) { convert_weights(p, 0, 8, cgw, cng, scr_, lane_); convert_weights(p, 1, 7, cgw, cng, scr_, lane_); }
                else convert_weights(p, 1, 8, cgw, cng, scr_, lane_); } } }
        GRID_BAR();
        { PHASE_BEGIN();
          pg8::Gemm g{(const bf16_t*)(p.ws + WS_ACT), (const bf16_t*)(p.ws + WS_WDN + (size_t)l * WS_WL1), M, D, DFF}; pg8::StaticOrder S; S.init(M, D, G_, bx);
          EpiRes E{XN, SSb + (size_t)(2 * l + 2) * 4 * M};
          { pg8::Unit uu; for (int i = 0; S.next(i, uu); ++i) ffn_fixup_tile(p, l, uu.pm, tid_);
            asm volatile("s_waitcnt vmcnt(0)" ::: "memory"); __syncthreads(); }
          if (l == 1 && G_ == 256) { EpiFinal EF{XN, p.out, p.in[14], (float*)(p.ws + WS_FSLOT), (unsigned*)(p.ws + WS_FCNT)};
              pg8::gemm_phase<EpiFinal, pg8::StaticOrder, true, true>(lds, g, S, EF, tid_); }
          else pg8::gemm_phase<EpiRes, pg8::StaticOrder, true, true>(lds, g, S, E, tid_); }
        if (!(l == 1 && gridDim.x == 256)) GRID_BAR();
}

__global__ void __launch_bounds__(NT, 2) hymba_fwd(Params p_arg) {
    extern __shared__ __attribute__((aligned(16))) unsigned char lds_raw[];
    cg::grid_group grid = cg::this_grid();
    LAS unsigned char* lds = (LAS unsigned char*)lds_raw;
    const int wave0 = __builtin_amdgcn_readfirstlane((int)threadIdx.x >> 6);
    if (threadIdx.x < 2) ((volatile LAS unsigned*)(lds + MISC_OFF))[threadIdx.x] = 0u;
    __syncthreads();
    (void)xcd_barrier_post((unsigned*)(p_arg.ws + WS_CTL), (volatile LAS unsigned*)(lds + MISC_OFF));
    if (p_arg.ws == nullptr) grid.sync();

    { PHASE_BEGIN();
      convert_weights(p, 0, 7, gw_, NGW, scr_, lane_);
      for (int i = gt_; i < 2 * 16384; i += GT) { const int l = i >> 14, j = (i >> 10) & 15, k = i & 1023; ((bf16_t*)(p.ws + WS_WG))[i] = (j < 8) ? f2bf1(p.in[2][(size_t)l * D * INW + (size_t)k * INW + 1536 + j] * p.in[1][l * D + k]) : (bf16_t)0; }
      for (int i = gt_; i < 2 * 4 * 128 * 128; i += GT) { const int c = i & 127, dc = (i >> 7) & 127, lg = i >> 14; ((bf16_t*)(p.ws + WS_WPT))[i] = f2bf1(p.in[6][(size_t)lg * 16384 + c * 128 + dc]); }
      for (int m0 = gw_ * 4; m0 < M; m0 += NGW * 4) {
          f32x4 v[4][4];
#pragma unroll
          for (int r = 0; r < 4; ++r)
#pragma unroll
              for (int j = 0; j < 4; ++j) v[r][j] = __builtin_nontemporal_load((const f32x4*)(p.in[0] + (size_t)(m0 + r) * D) + lane_ + 64 * j);
#pragma unroll
          for (int r = 0; r < 4; ++r) { float s = 0.f;
#pragma unroll
              for (int j = 0; j < 4; ++j) { const f32x4 x = v[r][j]; s += (x[0] * x[0] + x[1] * x[1]) + (x[2] * x[2] + x[3] * x[3]);
                  u32x2 o; o.x = pk_bf16(x[0], x[1]); o.y = pk_bf16(x[2], x[3]); *((u32x2*)(XN + (size_t)(m0 + r) * D) + lane_ + 64 * j) = o; }
              s = wave_sum(s, lane_); if (lane_ == 0) *(f32x4*)(SSb + (size_t)(m0 + r) * 4) = (f32x4){s, 0.f, 0.f, 0.f}; }
      } }
    GRID_BAR();

    layer_body<0>(lds, wave0);
    layer_body<1>(lds, wave0);
    if (gridDim.x != 256) { PHASE_BEGIN(); const float* SSf = SSb + (size_t)4 * 4 * M; const float* gf = p.in[14];
      f32x4 gg[4];
#pragma unroll
      for (int j = 0; j < 4; ++j) gg[j] = *((const f32x4*)gf + lane_ + 64 * j);
      for (int m0 = gw_ * 4; m0 < M; m0 += NGW * 4) {
          u32x2 v[4][4]; float rs[4];
#pragma unroll
          for (int r = 0; r < 4; ++r) { rs[r] = ss_row(SSf, m0 + r);
#pragma unroll
              for (int j = 0; j < 4; ++j) v[r][j] = __builtin_nontemporal_load((const u32x2*)(XN + (size_t)(m0 + r) * D) + lane_ + 64 * j); }
#pragma unroll
          for (int r = 0; r < 4; ++r) { const float sc = rsqrtf(rs[r] * (1.f / D) + EPS);
#pragma unroll
              for (int j = 0; j < 4; ++j) { const f32x4 x = (f32x4){bf_lo(v[r][j].x), bf_hi(v[r][j].x), bf_lo(v[r][j].y), bf_hi(v[r][j].y)};
                  __builtin_nontemporal_store(x * sc * gg[j], (f32x4*)(p.out + (size_t)(m0 + r) * D) + lane_ + 64 * j); } }
      } }
}

extern "C" void kernel_launch(void* const* d_in, const int* in_sizes, int n_in, void* d_out, int out_size, void* d_ws, size_t ws_size, hipStream_t stream) {
    static int grid = 0;
    if (grid == 0) {
        if (n_in != 15 || in_sizes[0] != M * D || out_size != M * D || ws_size < WS_END) { fprintf(stderr, "kernel_launch: unexpected shapes (n_in %d, in0 %d, out %d, ws %zu)\n", n_in, n_in > 0 ? in_sizes[0] : -1, out_size, ws_size); grid = -1; return; }
        int dev = 0, cus = 0, per_cu = 0;
        if (hipGetDevice(&dev) != hipSuccess || hipDeviceGetAttribute(&cus, hipDeviceAttributeMultiprocessorCount, dev) != hipSuccess) { grid = -1; return; }
        if (hipFuncSetAttribute((const void*)hymba_fwd, hipFuncAttributeMaxDynamicSharedMemorySize, LDS_BYTES) != hipSuccess) { fprintf(stderr, "kernel_launch: hipFuncSetAttribute failed\n"); grid = -1; return; }
        if (hipOccupancyMaxActiveBlocksPerMultiprocessor(&per_cu, (const void*)hymba_fwd, NT, LDS_BYTES) != hipSuccess || per_cu < 1) { fprintf(stderr, "kernel_launch: occupancy query says %d blocks per CU\n", per_cu); per_cu = 1; }
        (void)hipGetLastError();
        grid = cus * per_cu;
    }
    if (grid < 0) return;
    if (hipMemsetAsync((char*)d_ws + WS_CTL, 0, 32768, stream) != hipSuccess) { fprintf(stderr, "kernel_launch: memset failed\n"); return; }
    Params p{};
    for (int i = 0; i < 15; ++i) p.in[i] = (const float*)d_in[i];
    p.out = (float*)d_out; p.ws = (unsigned char*)d_ws;
    void* args[] = {&p};
    hipError_t e = hipLaunchCooperativeKernel((const void*)hymba_fwd, dim3(grid), dim3(NT), args, LDS_BYTES, stream);
    if (e != hipSuccess) fprintf(stderr, "kernel_launch: cooperative launch failed: %s (grid %d)\n", hipGetErrorString(e), grid);
}
```

```cpp
#include <hip/hip_runtime.h>
#include <hip/hip_cooperative_groups.h>
#include <cstdio>
#include <cstdint>
namespace cg = cooperative_groups;
namespace pg8 {
#define PG8_LAS __attribute__((address_space(3)))
typedef unsigned short bf16_t;
typedef short bf16x8 __attribute__((ext_vector_type(8)));
typedef float f32x4 __attribute__((ext_vector_type(4)));
typedef unsigned u32x4 __attribute__((ext_vector_type(4)));
constexpr int BM = 256, BK = 64, HALF = 128, HTB = HALF * BK * 2  , STAGE_BYTES = 8 * HTB, NXCD = 8;

__host__ __device__ __forceinline__ int lds_byte(int r, int c) { const int st = (r >> 4) * 2 + (c >> 5), rr = r & 15, cc = c & 31, ob = rr * 64 + cc * 2; return st * 1024 + (ob ^ (((ob >> 9) & 1) << 5)); }
__host__ __device__ __forceinline__ void stage_rc(int b, int& R, int& C) { const int st = b / 1024, sb = b % 1024, swz = sb ^ (((sb >> 9) & 1) << 5); R = (st >> 1) * 16 + swz / 64; C = (st & 1) * 32 + (swz % 64) / 2; }
__host__ __device__ __forceinline__ int perm32(int rho) { const int n = rho >> 4, i = rho & 15; return 8 * (i >> 2) + 4 * n + (i & 3); }

struct Unit { int pm, pn; };
struct Gemm { const bf16_t* A; const bf16_t* Bt; int M, N, K; };

struct StaticOrder {
    int nM, nN, nwg, G, c, WGM;
    __host__ __device__ void init(int M, int N, int G_, int c_, int wgm = 4) { nM = M / BM; nN = N / BM; nwg = nM * nN; G = G_; c = c_; WGM = wgm; }
    __host__ __device__ bool next(int i, Unit& u) const {
        const long L = (long)i * G + c; if (L >= nwg) return false;
        int wgid = (int)L; { const int q = nwg / NXCD, r = nwg % NXCD, xcd = wgid % NXCD, off = wgid / NXCD; wgid = (xcd < r ? xcd * (q + 1) : r * (q + 1) + (xcd - r) * q) + off; }
        const int nig = WGM * nN, gid = wgid / nig, fm = gid * WGM, gsz = (nM - fm) < WGM ? (nM - fm) : WGM;
        u.pm = fm + ((wgid % nig) % gsz); u.pn = (wgid % nig) / gsz; return true;
    }
    __device__ __forceinline__ void a_ready(const Unit&) const {}
    __device__ __forceinline__ void done(const Unit&) const {}
};
template <class Epi, class Sched, bool ALIGN_EPI = false, bool SP2 = false>
__device__ __forceinline__ void gemm_phase(PG8_LAS unsigned char* lds, const Gemm g, const Sched& S, const Epi& E, int tid) {
    asm volatile("" : "+v"(tid));
    const int wid = __builtin_amdgcn_readfirstlane(tid >> 6), lane = tid & 63, wr = wid >> 2, wc = wid & 3, fr = lane & 15, fq = lane >> 4;
    const int K = g.K, nt = K / BK;
    unsigned voffA[2], voffB[2];
#pragma unroll
    for (int i = 0; i < 2; ++i) { int R, C; stage_rc(tid * 16 + i * 8192, R, C); const int Rb = Epi::PERM ? ((R & ~31) + perm32(R & 31)) : R;
        const int Ra = Epi::ROWPERM ? ((((R >> 6) * 16 + (R & 15)) * 8) + ((R >> 4) & 3)) : R;
        voffA[i] = (unsigned)(Ra * K + C) * 2u; voffB[i] = (unsigned)(Rb * K + C) * 2u; }
    const size_t kstep = (size_t)(BK * 2);
    const size_t hstepB = (size_t)HALF * K * 2;
    const size_t hstepA = Epi::ROWPERM ? (size_t)4 * K * 2 : hstepB;
    const size_t tstep = 2 * hstepB;
    const unsigned ldsw = (unsigned)wid * 1024u;
    const int aoff = lds_byte(wr * 64 + fr, fq * 8), boff = lds_byte(wc * 32 + fr, fq * 8);
#define PG8_SA(b, h) (((b) * 2 + (h)) * HTB)
#define PG8_SB(b, h) ((4 + (b) * 2 + (h)) * HTB)
#define PG8_STAGE(bufoff, gbase, voff) do { _Pragma("unroll") for (int _i = 0; _i < 2; ++_i) \
        __builtin_amdgcn_global_load_lds((const unsigned*)((const char*)(gbase) + (voff)[_i]), (PG8_LAS unsigned*)(lds + (bufoff) + ldsw + _i * 8192), 16, 0, 0); } while (0)
#define PG8_LDA(dst, b, h) do { _Pragma("unroll") for (int m = 0; m < 4; ++m) _Pragma("unroll") for (int k = 0; k < 2; ++k) dst[m][k] = *(const PG8_LAS bf16x8*)(lds + PG8_SA(b, h) + aoff + m * 2048 + k * 1024); } while (0)
#define PG8_LDB(dst, b, h) do { _Pragma("unroll") for (int n = 0; n < 2; ++n) _Pragma("unroll") for (int k = 0; k < 2; ++k) dst[n][k] = *(const PG8_LAS bf16x8*)(lds + PG8_SB(b, h) + boff + n * 2048 + k * 1024); } while (0)
#define PG8_MMA(ai, bj, At, Bt) do { __builtin_amdgcn_s_setprio(1); _Pragma("unroll") for (int m = 0; m < 4; ++m) _Pragma("unroll") for (int n = 0; n < 2; ++n) _Pragma("unroll") for (int k = 0; k < 2; ++k) \
        acc[ai][bj][m][n] = __builtin_amdgcn_mfma_f32_16x16x32_bf16(Bt[n][k], At[m][k], acc[ai][bj][m][n], 0, 0, 0); __builtin_amdgcn_s_setprio(0); } while (0)
#define PG8_WAIT_V(n) asm volatile("s_waitcnt vmcnt(" #n ")" ::: "memory")
#define PG8_WAIT_L(n) asm volatile("s_waitcnt lgkmcnt(" #n ")" ::: "memory")
#define PG8_BAR __builtin_amdgcn_s_barrier()
#define PG8_SCHED __builtin_amdgcn_sched_barrier(0)
    Unit cur, nxt; int ui = 0;
    if (!S.next(0, cur)) return;
    f32x4 acc[2][2][4][2];
#pragma unroll
    for (int a = 0; a < 2; ++a)
#pragma unroll
        for (int b = 0; b < 2; ++b)
#pragma unroll
            for (int m = 0; m < 4; ++m)
#pragma unroll
                for (int n = 0; n < 2; ++n) acc[a][b][m][n] = (f32x4){0.f, 0.f, 0.f, 0.f};
    bf16x8 At[4][2], B0[2][2], B1[2][2];
    const char* cA = (const char*)g.A + (size_t)cur.pm * tstep; const char* cB = (const char*)g.Bt + (size_t)cur.pn * tstep;
    if constexpr (SP2) {
        PG8_STAGE(PG8_SB(0, 0), cB, voffB); PG8_STAGE(PG8_SB(0, 1), cB + hstepB, voffB); PG8_STAGE(PG8_SA(0, 0), cA, voffA); PG8_STAGE(PG8_SA(0, 1), cA + hstepA, voffA);
        if (wr == 1) PG8_BAR;
        PG8_WAIT_V(2); PG8_BAR;
        PG8_STAGE(PG8_SB(1, 0), cB + kstep, voffB); PG8_STAGE(PG8_SA(1, 0), cA + kstep, voffA); PG8_STAGE(PG8_SB(1, 1), cB + hstepB + kstep, voffB);
        PG8_WAIT_V(6); PG8_BAR;
    } else {
        PG8_STAGE(PG8_SB(0, 0), cB, voffB); PG8_STAGE(PG8_SA(0, 0), cA, voffA); PG8_STAGE(PG8_SB(0, 1), cB + hstepB, voffB); PG8_STAGE(PG8_SA(0, 1), cA + hstepA, voffA);
        if (wr == 1) PG8_BAR;
        PG8_WAIT_V(4); PG8_BAR;
        PG8_STAGE(PG8_SB(1, 0), cB + kstep, voffB); PG8_STAGE(PG8_SA(1, 0), cA + kstep, voffA); PG8_STAGE(PG8_SB(1, 1), cB + hstepB + kstep, voffB);
        PG8_WAIT_V(6); PG8_BAR;
    }
    for (;;) {
        const bool has_next = S.next(ui + 1, nxt);
        const char* nA = has_next ? (const char*)g.A + (size_t)nxt.pm * tstep : cA; const char* nB = has_next ? (const char*)g.Bt + (size_t)nxt.pn * tstep : cB;
        for (int t = 0; t < nt; t += 2) {
            const bool last = (t == nt - 2);
            const char* a1 = cA + (size_t)(t + 1) * kstep;
            const char* a2 = last ? nA : cA + (size_t)(t + 2) * kstep; const char* b2 = last ? nB : cB + (size_t)(t + 2) * kstep;
            const char* a3 = a2 + kstep; const char* b3 = b2 + kstep;
            if constexpr (SP2) {
            PG8_LDB(B0, 0, 0); PG8_LDB(B1, 0, 1); PG8_SCHED; PG8_LDA(At, 0, 0); PG8_STAGE(PG8_SA(1, 1), a1 + hstepA, voffA);
            PG8_WAIT_V(8); PG8_WAIT_L(0); PG8_BAR; PG8_MMA(0, 0, At, B0); PG8_MMA(0, 1, At, B1); PG8_BAR; PG8_SCHED;
            PG8_LDA(At, 0, 1); PG8_STAGE(PG8_SB(0, 0), b2, voffB); PG8_STAGE(PG8_SB(0, 1), b2 + hstepB, voffB); PG8_STAGE(PG8_SA(0, 0), a2, voffA);
            PG8_WAIT_V(8); PG8_WAIT_L(0); PG8_BAR; PG8_MMA(1, 0, At, B0); PG8_MMA(1, 1, At, B1); PG8_BAR; PG8_SCHED;
            PG8_LDB(B0, 1, 0); PG8_LDB(B1, 1, 1); PG8_SCHED; PG8_LDA(At, 1, 0); PG8_STAGE(PG8_SA(0, 1), a2 + hstepA, voffA);
            PG8_WAIT_V(8); PG8_WAIT_L(0); PG8_BAR; PG8_MMA(0, 0, At, B0); PG8_MMA(0, 1, At, B1); PG8_BAR; PG8_SCHED;
            PG8_LDA(At, 1, 1); PG8_STAGE(PG8_SB(1, 0), b3, voffB); PG8_STAGE(PG8_SB(1, 1), b3 + hstepB, voffB); PG8_STAGE(PG8_SA(1, 0), a3, voffA);
            PG8_WAIT_V(8); PG8_WAIT_L(0); PG8_BAR; PG8_MMA(1, 0, At, B0); PG8_MMA(1, 1, At, B1); PG8_BAR; PG8_SCHED;
            } else {
            PG8_LDB(B0, 0, 0); PG8_SCHED; PG8_LDA(At, 0, 0); PG8_STAGE(PG8_SA(1, 1), a1 + hstepA, voffA);
            PG8_WAIT_L(8); PG8_BAR; PG8_WAIT_L(0); PG8_MMA(0, 0, At, B0); PG8_BAR; PG8_SCHED;
            PG8_LDB(B1, 0, 1); PG8_STAGE(PG8_SB(0, 0), b2, voffB);
            PG8_BAR; PG8_WAIT_L(0); PG8_MMA(0, 1, At, B1); PG8_BAR;
            PG8_LDA(At, 0, 1); PG8_STAGE(PG8_SA(0, 0), a2, voffA);
            PG8_BAR; PG8_WAIT_L(0); PG8_MMA(1, 0, At, B0); PG8_BAR; PG8_SCHED;
            PG8_STAGE(PG8_SB(0, 1), b2 + hstepB, voffB);
            PG8_WAIT_V(6); PG8_BAR; PG8_MMA(1, 1, At, B1); PG8_BAR;
            PG8_LDB(B0, 1, 0); PG8_SCHED; PG8_LDA(At, 1, 0); PG8_STAGE(PG8_SA(0, 1), a2 + hstepA, voffA);
            PG8_WAIT_L(8); PG8_BAR; PG8_WAIT_L(0); PG8_MMA(0, 0, At, B0); PG8_BAR; PG8_SCHED;
            PG8_LDB(B1, 1, 1); PG8_STAGE(PG8_SB(1, 0), b3, voffB);
            PG8_BAR; PG8_WAIT_L(0); PG8_MMA(0, 1, At, B1); PG8_BAR;
            PG8_LDA(At, 1, 1); PG8_STAGE(PG8_SA(1, 0), a3, voffA);
            PG8_BAR; PG8_WAIT_L(0); PG8_MMA(1, 0, At, B0); PG8_BAR; PG8_SCHED;
            PG8_STAGE(PG8_SB(1, 1), b3 + hstepB, voffB);
            PG8_WAIT_V(6); PG8_BAR; PG8_MMA(1, 1, At, B1); PG8_BAR;
            }
        }
        if constexpr (ALIGN_EPI) { if (wr == 0) PG8_BAR; }
        E(acc, cur, wr, wc, fr, fq, lds, ui);
        if (!has_next) break;
#pragma unroll
        for (int a = 0; a < 2; ++a)
#pragma unroll
            for (int b = 0; b < 2; ++b)
#pragma unroll
                for (int m = 0; m < 4; ++m)
#pragma unroll
                    for (int n = 0; n < 2; ++n) acc[a][b][m][n] = (f32x4){0.f, 0.f, 0.f, 0.f};
        cur = nxt; cA = nA; cB = nB; ++ui;
        if constexpr (ALIGN_EPI) { if (wr == 1) PG8_BAR; }
    }
    PG8_WAIT_V(0);
    if constexpr (!ALIGN_EPI) { if (wr == 0) PG8_BAR; }
    PG8_BAR;
#undef PG8_SA
#undef PG8_SB
#undef PG8_STAGE
#undef PG8_LDA
#undef PG8_LDB
#undef PG8_MMA
#undef PG8_WAIT_V
#undef PG8_WAIT_L
#undef PG8_BAR
#undef PG8_SCHED
}
}

#define LAS __attribute__((address_space(3)))
typedef unsigned short bf16_t;
typedef float f32x4 __attribute__((ext_vector_type(4)));
typedef unsigned u32x4 __attribute__((ext_vector_type(4)));
typedef unsigned u32x2 __attribute__((ext_vector_type(2)));

constexpr int D = 1024, BATCH = 4, SEQ = 4096, M = BATCH * SEQ;
constexpr int NH = 4, DV = 128, DK = 64, CH = 64, NCH = SEQ / CH;
constexpr int NP = 2048, DFF = 2816, INW = 2056;
constexpr int NUNIT = BATCH * NH * NCH;
constexpr float EPS = 1e-6f;
constexpr int NT = 512, NWAVES = 8;

constexpr size_t MiB = 1u << 20;
constexpr size_t WS_WIN = 0, WS_WOUT = 4 * MiB, WS_WUP = 6 * MiB, WS_WDN = 17 * MiB;
constexpr size_t WS_WL1 = 100 * MiB;
constexpr size_t WS_FSLOT = 124 * MiB;
constexpr size_t WS_FCNT = 31 * MiB + 16384;
constexpr size_t WS_SMALL = 23 * MiB;
constexpr size_t WS_WG = WS_SMALL;
constexpr size_t WS_G = WS_SMALL + 64 * 1024;
constexpr size_t WS_SS = 80 * MiB;
constexpr size_t WS_BL = WS_G + 512 * 1024 + 320 * 1024;
constexpr size_t WS_ML = WS_BL + 4096;
constexpr size_t WS_MP = WS_ML + 4096;
constexpr size_t WS_NST = WS_SMALL + 1 * MiB;
constexpr size_t WS_WPT = WS_SMALL + 1 * MiB + 256 * 1024;
constexpr size_t WS_QKC = 84 * MiB;
constexpr size_t WS_CPB = 64 * MiB;
constexpr size_t WS_HEAD = WS_SMALL + 2 * MiB;
constexpr size_t WS_TAIL = WS_SMALL + 5 * MiB;
constexpr size_t WS_XN = 32 * MiB;
constexpr size_t WS_XA = 64 * MiB;
constexpr size_t WS_P = 128 * MiB;
constexpr size_t WS_CST = 192 * MiB;
constexpr size_t WS_HCAT = 224 * MiB;
constexpr size_t WS_ACT = 128 * MiB;
constexpr size_t WS_END = 256 * MiB;
constexpr int LDS_BYTES = 163840;
constexpr int RST_OFF = 131072;
constexpr int XCH_OFF = 155648;
constexpr int MISC_OFF = 159744;
constexpr size_t WS_CTL = 31 * MiB;

struct Params { const float* in[15]; float* out; unsigned char* ws; };

__device__ __forceinline__ float bf_lo(unsigned w) { return __uint_as_float(w << 16); }
__device__ __forceinline__ float bf_hi(unsigned w) { return __uint_as_float(w & 0xffff0000u); }
__device__ __forceinline__ unsigned pk_bf16(float lo, float hi) { unsigned r; asm volatile("v_cvt_pk_bf16_f32 %0, %1, %2" : "=v"(r) : "v"(lo), "v"(hi)); return r; }
__device__ __forceinline__ void unpack8(const u32x4 w, float (&x)[8]) { x[0] = bf_lo(w.x); x[1] = bf_hi(w.x); x[2] = bf_lo(w.y); x[3] = bf_hi(w.y); x[4] = bf_lo(w.z); x[5] = bf_hi(w.z); x[6] = bf_lo(w.w); x[7] = bf_hi(w.w); }
__device__ __forceinline__ float shfl_idx(float v, int src) { return __builtin_bit_cast(float, __builtin_amdgcn_ds_bpermute(src << 2, __builtin_bit_cast(int, v))); }
__device__ __forceinline__ float wave_sum(float v, int lane) {
#pragma unroll
    for (int o = 1; o < 64; o <<= 1) v += shfl_idx(v, lane ^ o);
    return v;
}
__device__ __forceinline__ float wave_max(float v, int lane) {
#pragma unroll
    for (int o = 1; o < 64; o <<= 1) v = fmaxf(v, shfl_idx(v, lane ^ o));
    return v;
}
__device__ __forceinline__ float wave_incl_sum(float v, int lane) {
#pragma unroll
    for (int o = 1; o < 64; o <<= 1) { const float t = shfl_idx(v, lane - o); if (lane >= o) v += t; }
    return v;
}
__device__ __forceinline__ float wave_incl_max(float v, int lane) {
#pragma unroll
    for (int o = 1; o < 64; o <<= 1) { const float t = shfl_idx(v, lane - o); if (lane >= o) v = fmaxf(v, t); }
    return v;
}
__device__ __forceinline__ float log_sigmoid(float x) { return fminf(x, 0.f) - log1pf(expf(-fabsf(x))); }
__device__ __forceinline__ float sigmoid_f(float x) { return 1.f / (1.f + expf(-x)); }
__device__ __forceinline__ float silu_f(float x) { return x / (1.f + expf(-x)); }
__device__ __forceinline__ float exp_fast(float x) { return __builtin_amdgcn_exp2f(x * 1.44269504f); }
__device__ __forceinline__ float sigmoid_fast(float x) { return __builtin_amdgcn_rcpf(1.f + __builtin_amdgcn_exp2f(x * -1.44269504f)); }
__device__ __forceinline__ float silu_fast(float x) { return x * sigmoid_fast(x); }
#define LDS_WAIT() asm volatile("s_waitcnt lgkmcnt(0)" ::: "memory")
__device__ __forceinline__ void store16_wt(__amdgpu_buffer_rsrc_t rsrc, unsigned byte_off, u32x4 v) { __builtin_amdgcn_raw_buffer_store_b128(v, rsrc, (int)byte_off, 0, 16); }
__device__ __forceinline__ float ss_row(const float* SS, int row) { const f32x4 v = *(const f32x4*)(SS + (size_t)row * 4); return (v[0] + v[1]) + (v[2] + v[3]); }

struct EpiIn {
    static constexpr bool PERM = true, ROWPERM = false;
    bf16_t* P; const float* SS;
    __device__ __forceinline__ void operator()(pg8::f32x4 (&acc)[2][2][4][2], const pg8::Unit& u, int wr, int wc, int fr, int fq, PG8_LAS unsigned char*, int) const {
        const int row0 = u.pm * 256 + wr * 64 + fr, col0 = u.pn * 256 + wc * 32 + 8 * fq;
        const __amdgpu_buffer_rsrc_t prs = __builtin_amdgcn_make_buffer_rsrc((void*)P, (short)0, (int)((size_t)M * NP * 2), 0x00020000);
#pragma unroll
        for (int ai = 0; ai < 2; ++ai)
#pragma unroll
            for (int m = 0; m < 4; ++m) {
                const int row = row0 + ai * 128 + m * 16;
                const float rs = rsqrtf(ss_row(SS, row) * (1.f / D) + EPS);
                bf16_t* rowp = P + (size_t)row * NP + col0;
#pragma unroll
                for (int bj = 0; bj < 2; ++bj) {
                    const pg8::f32x4 v0 = acc[ai][bj][m][0] * rs, v1 = acc[ai][bj][m][1] * rs;
                    u32x4 w; w.x = pk_bf16(v0[0], v0[1]); w.y = pk_bf16(v0[2], v0[3]); w.z = pk_bf16(v1[0], v1[1]); w.w = pk_bf16(v1[2], v1[3]);
                    store16_wt(prs, (unsigned)(((size_t)row * NP + col0 + bj * 128) * 2), w);
                }
            }
    }
};
struct EpiRes {
    static constexpr bool PERM = true, ROWPERM = false;
    bf16_t* xn; float* ss;
    __device__ __forceinline__ void operator()(pg8::f32x4 (&acc)[2][2][4][2], const pg8::Unit& u, int wr, int wc, int fr, int fq, PG8_LAS unsigned char* lds, int ui) const {
        const int row0 = u.pm * 256 + wr * 64 + fr, col0 = u.pn * 256 + wc * 32 + 8 * fq;
        PG8_LAS float* xs = (PG8_LAS float*)(lds + XCH_OFF);
        const __amdgpu_buffer_rsrc_t xrs = __builtin_amdgcn_make_buffer_rsrc((void*)xn, (short)0, (int)((size_t)M * D * 2), 0x00020000);
#pragma unroll
        for (int ai = 0; ai < 2; ++ai) {
            u32x4 r[4][2];
#pragma unroll
            for (int m = 0; m < 4; ++m)
#pragma unroll
                for (int bj = 0; bj < 2; ++bj) r[m][bj] = *(const u32x4*)(xn + (size_t)(row0 + ai * 128 + m * 16) * D + col0 + bj * 128);
#pragma unroll
            for (int m = 0; m < 4; ++m) {
                const int row = row0 + ai * 128 + m * 16;
                const size_t off = (size_t)row * D + col0;
                float part = 0.f;
#pragma unroll
                for (int bj = 0; bj < 2; ++bj) {
                    const u32x4 rv = r[m][bj];
                    const pg8::f32x4 o0 = acc[ai][bj][m][0] + (pg8::f32x4){bf_lo(rv.x), bf_hi(rv.x), bf_lo(rv.y), bf_hi(rv.y)};
                    const pg8::f32x4 o1 = acc[ai][bj][m][1] + (pg8::f32x4){bf_lo(rv.z), bf_hi(rv.z), bf_lo(rv.w), bf_hi(rv.w)};
                    u32x4 w; w.x = pk_bf16(o0[0], o0[1]); w.y = pk_bf16(o0[2], o0[3]); w.z = pk_bf16(o1[0], o1[1]); w.w = pk_bf16(o1[2], o1[3]);
                    store16_wt(xrs, (unsigned)((off + bj * 128) * 2), w);
                    part += ((o0[0] * o0[0] + o0[1] * o0[1]) + (o0[2] * o0[2] + o0[3] * o0[3])) + ((o1[0] * o1[0] + o1[1] * o1[1]) + (o1[2] * o1[2] + o1[3] * o1[3]));
                }
                { const int ln = fq * 16 + fr; part += shfl_idx(part, ln ^ 16); part += shfl_idx(part, ln ^ 32); }
                if (fq == 0) xs[(ai * 128 + wr * 64 + m * 16 + fr) * 4 + wc] = part;
            }
            asm volatile("" ::: "memory");
        }
        LDS_WAIT(); __builtin_amdgcn_s_barrier(); asm volatile("" ::: "memory");
        if (wr == 0) { const int r = wc * 64 + fq * 16 + fr; const pg8::f32x4 v = *(PG8_LAS pg8::f32x4*)(xs + r * 4);
            ss[(size_t)(u.pm * 256 + r) * 4 + u.pn] = (v[0] + v[1]) + (v[2] + v[3]); }
        LDS_WAIT(); __builtin_amdgcn_s_barrier(); asm volatile("" ::: "memory");
    }
};
struct EpiFinal {
    static constexpr bool PERM = true, ROWPERM = false;
    const bf16_t* xn; float* out; const float* gf; float* slots; unsigned* cnt;
    __device__ __forceinline__ void operator()(pg8::f32x4 (&acc)[2][2][4][2], const pg8::Unit& u, int wr, int wc, int fr, int fq, PG8_LAS unsigned char* lds, int ui) const {
        const int row0 = u.pm * 256 + wr * 64 + fr, col0 = u.pn * 256 + wc * 32 + 8 * fq;
        PG8_LAS float* xs = (PG8_LAS float*)(lds + XCH_OFF);
#pragma unroll
        for (int ai = 0; ai < 2; ++ai) {
            u32x4 r[4][2];
#pragma unroll
            for (int m = 0; m < 4; ++m)
#pragma unroll
                for (int bj = 0; bj < 2; ++bj) r[m][bj] = *(const u32x4*)(xn + (size_t)(row0 + ai * 128 + m * 16) * D + col0 + bj * 128);
#pragma unroll
            for (int m = 0; m < 4; ++m) {
                float part = 0.f;
#pragma unroll
                for (int bj = 0; bj < 2; ++bj) {
                    const u32x4 rv = r[m][bj];
                    const pg8::f32x4 o0 = acc[ai][bj][m][0] + (pg8::f32x4){bf_lo(rv.x), bf_hi(rv.x), bf_lo(rv.y), bf_hi(rv.y)};
                    const pg8::f32x4 o1 = acc[ai][bj][m][1] + (pg8::f32x4){bf_lo(rv.z), bf_hi(rv.z), bf_lo(rv.w), bf_hi(rv.w)};
                    acc[ai][bj][m][0] = o0; acc[ai][bj][m][1] = o1;
                    part += ((o0[0] * o0[0] + o0[1] * o0[1]) + (o0[2] * o0[2] + o0[3] * o0[3])) + ((o1[0] * o1[0] + o1[1] * o1[1]) + (o1[2] * o1[2] + o1[3] * o1[3]));
                }
                { const int ln = fq * 16 + fr; part += shfl_idx(part, ln ^ 16); part += shfl_idx(part, ln ^ 32); }
                if (fq == 0) xs[(ai * 128 + wr * 64 + m * 16 + fr) * 4 + wc] = part;
            }
            asm volatile("" ::: "memory");
        }
        LDS_WAIT(); __builtin_amdgcn_s_barrier(); asm volatile("" ::: "memory");
        unsigned* pc = cnt + 64 * u.pm;
        if (wr == 0) {
            const int r = wc * 64 + fq * 16 + fr; const pg8::f32x4 v = *(PG8_LAS pg8::f32x4*)(xs + r * 4);
            __hip_atomic_store(slots + (size_t)u.pn * M + u.pm * 256 + r, (v[0] + v[1]) + (v[2] + v[3]), __ATOMIC_RELAXED, __HIP_MEMORY_SCOPE_AGENT);
            asm volatile("s_waitcnt vmcnt(0)" ::: "memory");
            if (fq == 0 && fr == 0) __hip_atomic_fetch_add(pc, 1u, __ATOMIC_RELAXED, __HIP_MEMORY_SCOPE_AGENT);
            if (wc == 0) {
                unsigned spins = 0;
                while ((unsigned)__builtin_amdgcn_readfirstlane((int)__hip_atomic_load(pc, __ATOMIC_RELAXED, __HIP_MEMORY_SCOPE_AGENT)) < 16u) { __builtin_amdgcn_s_sleep(2); if (++spins > (1u << 22)) break; }
                __builtin_amdgcn_fence(__ATOMIC_ACQUIRE, "agent");
                asm volatile("s_waitcnt vmcnt(0)" ::: "memory");
            }
        }
        asm volatile("s_waitcnt vmcnt(0) lgkmcnt(0)" ::: "memory"); __builtin_amdgcn_s_barrier(); asm volatile("" ::: "memory");
#pragma unroll
        for (int ai = 0; ai < 2; ++ai)
#pragma unroll
            for (int m = 0; m < 4; ++m) {
                const int row = row0 + ai * 128 + m * 16;
                float t4[4];
#pragma unroll
                for (int t = 0; t < 4; ++t) t4[t] = __hip_atomic_load(slots + (size_t)t * M + row, __ATOMIC_RELAXED, __HIP_MEMORY_SCOPE_AGENT);
                const float rs = rsqrtf(((t4[0] + t4[1]) + (t4[2] + t4[3])) * (1.f / D) + EPS);
#pragma unroll
                for (int bj = 0; bj < 2; ++bj) {
                    const pg8::f32x4 g0 = *(const pg8::f32x4*)(gf + col0 + bj * 128), g1 = *(const pg8::f32x4*)(gf + col0 + bj * 128 + 4);
                    __builtin_nontemporal_store(acc[ai][bj][m][0] * rs * g0, (pg8::f32x4*)(out + (size_t)row * D + col0 + bj * 128));
                    __builtin_nontemporal_store(acc[ai][bj][m][1] * rs * g1, (pg8::f32x4*)(out + (size_t)row * D + col0 + bj * 128 + 4));
                }
            }
        LDS_WAIT(); __builtin_amdgcn_s_barrier(); asm volatile("" ::: "memory");
    }
};
struct EpiUp {
    static constexpr bool PERM = true, ROWPERM = true;
    bf16_t* ACT; const float* SS; const float* cw; const float* cb; float* HEAD; float* TAIL;
    __device__ __forceinline__ void operator()(pg8::f32x4 (&acc)[2][2][4][2], const pg8::Unit& u, int wr, int wc, int fr, int fq, PG8_LAS unsigned char* lds, int ui) const {
        asm volatile("" : "+v"(fr), "+v"(fq));
        const int tok0 = u.pm * 256 + (wr * 16 + fr) * 8;
        const int cbase = u.pn * 128 + wc * 32 + 8 * fq;
        const __amdgpu_buffer_rsrc_t ars = __builtin_amdgcn_make_buffer_rsrc((void*)ACT, (short)0, (int)((size_t)M * DFF * 2), 0x00020000);
#pragma unroll
        for (int ai = 0; ai < 2; ++ai) {
            const pg8::f32x4 rs4 = *(PG8_LAS pg8::f32x4*)(lds + RST_OFF + (ui * 256 + (wr * 16 + fr) * 8 + ai * 4) * 4);
#pragma unroll
            for (int m = 0; m < 4; ++m)
#pragma unroll
                for (int bj = 0; bj < 2; ++bj)
#pragma unroll
                    for (int n = 0; n < 2; ++n) acc[ai][bj][m][n] *= rs4[m];
        }
        PG8_LAS float* xch = (PG8_LAS float*)(lds + XCH_OFF) + (wc * 4 + fq) * 64;
        if (fr == 15) {
            if (wr == 0) {
#pragma unroll
                for (int tk = 0; tk < 2; ++tk)
#pragma unroll
                    for (int bj = 0; bj < 2; ++bj)
#pragma unroll
                        for (int n = 0; n < 2; ++n) *(PG8_LAS pg8::f32x4*)(xch + tk * 32 + bj * 8 + n * 4) = acc[1][bj][2 + tk][n];
            } else {
#pragma unroll
                for (int tk = 0; tk < 2; ++tk)
#pragma unroll
                    for (int bj = 0; bj < 2; ++bj)
#pragma unroll
                        for (int n = 0; n < 2; ++n) *(pg8::f32x4*)(TAIL + ((size_t)u.pm * 2 + tk) * (2 * DFF) + bj * DFF + cbase + 4 * n) = acc[1][bj][2 + tk][n];
            }
        }
        if (fr == 0 && wr == 0) {
#pragma unroll
            for (int tk = 0; tk < 2; ++tk)
#pragma unroll
                for (int bj = 0; bj < 2; ++bj)
#pragma unroll
                    for (int n = 0; n < 2; ++n) *(pg8::f32x4*)(HEAD + ((size_t)u.pm * 2 + tk) * (2 * DFF) + bj * DFF + cbase + 4 * n) = acc[0][bj][tk][n];
        }
        LDS_WAIT(); __builtin_amdgcn_s_barrier(); asm volatile("" ::: "memory");
#pragma unroll
        for (int n = 0; n < 2; ++n)
#pragma unroll
            for (int bj = 0; bj < 2; ++bj) {
                const int cc = bj * DFF + cbase + 4 * n;
                const pg8::f32x4 w0 = *(const pg8::f32x4*)(cw + cc), w1 = *(const pg8::f32x4*)(cw + 2 * DFF + cc), w2 = *(const pg8::f32x4*)(cw + 4 * DFF + cc), bb = *(const pg8::f32x4*)(cb + cc);
                pg8::f32x4 p1, p2;
#pragma unroll
                for (int j = 0; j < 4; ++j) {
                    p1[j] = shfl_idx(acc[1][bj][3][n][j], fq * 16 + fr - 1);
                    p2[j] = shfl_idx(acc[1][bj][2][n][j], fq * 16 + fr - 1);
                }
                if (fr == 0) {
                    if (wr == 1) { p2 = *(PG8_LAS pg8::f32x4*)(xch + 0 * 32 + bj * 8 + n * 4); p1 = *(PG8_LAS pg8::f32x4*)(xch + 1 * 32 + bj * 8 + n * 4); }
                    else { p1 = p2 = (pg8::f32x4){0.f, 0.f, 0.f, 0.f}; }
                }
#pragma unroll
                for (int t = 7; t >= 0; --t) {
                    const pg8::f32x4 x0 = acc[t >> 2][bj][t & 3][n];
                    const pg8::f32x4 x1 = (t >= 1) ? acc[(t - 1) >> 2][bj][(t - 1) & 3][n] : p1;
                    const pg8::f32x4 x2 = (t >= 2) ? acc[(t - 2) >> 2][bj][(t - 2) & 3][n] : (t == 1 ? p1 : p2);
                    acc[t >> 2][bj][t & 3][n] = w0 * x2 + w1 * x1 + w2 * x0 + bb;
                }
                asm volatile("" ::: "memory");
            }
#pragma unroll
        for (int t = 0; t < 8; ++t) {
            if (t < 2 && fr == 0 && wr == 0) continue;
            pg8::f32x4 a, b;
#pragma unroll
            for (int j = 0; j < 4; ++j) {
                const float g0 = acc[t >> 2][0][t & 3][0][j], g1 = acc[t >> 2][0][t & 3][1][j];
                a[j] = g0 * __builtin_amdgcn_rcpf(1.f + __builtin_amdgcn_exp2f(-1.44269504f * g0)) * acc[t >> 2][1][t & 3][0][j];
                b[j] = g1 * __builtin_amdgcn_rcpf(1.f + __builtin_amdgcn_exp2f(-1.44269504f * g1)) * acc[t >> 2][1][t & 3][1][j];
            }
            u32x4 w; w.x = pk_bf16(a[0], a[1]); w.y = pk_bf16(a[2], a[3]); w.z = pk_bf16(b[0], b[1]); w.w = pk_bf16(b[2], b[3]);
            store16_wt(ars, (unsigned)(((size_t)(tok0 + t) * DFF + cbase) * 2), w);
        }
    }
};

__device__ __forceinline__ void transpose_item(const float* W, int ldw, int src_col0, int k0, bf16_t* WT, int K, int dst_row0, const float* gain, LAS float* scr, int lane) {
#pragma unroll
    for (int h2 = 0; h2 < 2; ++h2) { float v[16];
#pragma unroll
        for (int i = 0; i < 16; ++i) { const int kk = 2 * (16 * h2 + i) + (lane >> 5); v[i] = __builtin_nontemporal_load(W + (size_t)(k0 + kk) * ldw + src_col0 + (lane & 31));   }
#pragma unroll
        for (int i = 0; i < 16; ++i) { const int kk = 2 * (16 * h2 + i) + (lane >> 5); scr[kk * 33 + (lane & 31)] = gain ? v[i] * gain[k0 + kk] : v[i]; } }
    LDS_WAIT();
    const int c = lane & 7;
#pragma unroll
    for (int j = 0; j < 4; ++j) { const int n = (lane >> 3) + 8 * j; const LAS float* s = scr + (8 * c) * 33 + n;
        u32x4 o; o.x = pk_bf16(s[0 * 33], s[1 * 33]); o.y = pk_bf16(s[2 * 33], s[3 * 33]); o.z = pk_bf16(s[4 * 33], s[5 * 33]); o.w = pk_bf16(s[6 * 33], s[7 * 33]);
        *(u32x4*)(WT + (size_t)(dst_row0 + n) * K + k0 + 8 * c) = o; }
    LDS_WAIT();
}
__device__ __forceinline__ void convert_weights(const Params& p, int l, int mask, int gw, int NGW, LAS float* scr, int lane) {
    const int n_in = (mask & 1) ? 1024 : 0, n_out = (mask & 2) ? 512 : 0, n_up = (mask & 4) ? 2816 : 0, n_dn = (mask & 8) ? 1408 : 0;
    const int total = n_in + n_out + n_up + n_dn;
    for (int it = gw; it < total; it += NGW) {
        int r = it;
        if (r < n_in) { const int kb = r >> 6, nb = r & 63;
            transpose_item(p.in[2] + (size_t)l * D * INW, INW, 32 * nb + (nb >= 48 ? 8 : 0), 64 * kb, (bf16_t*)(p.ws + WS_WIN + (size_t)l * WS_WL1), D, 32 * nb, p.in[1] + l * D, scr, lane); continue; }
        r -= n_in;
        if (r < n_out) { const int kb = r >> 5, nb = r & 31;
            transpose_item(p.in[8] + (size_t)l * D * D, D, 32 * nb, 64 * kb, (bf16_t*)(p.ws + WS_WOUT + (size_t)l * WS_WL1), D, 32 * nb, nullptr, scr, lane); continue; }
        r -= n_out;
        if (r < n_up) { const int kb = r / 176, nb = r % 176, pn = nb >> 3, j = nb & 7; const int src = (j < 4) ? 128 * pn + 32 * j : DFF + 128 * pn + 32 * (j - 4);
            transpose_item(p.in[10] + (size_t)l * D * 2 * DFF, 2 * DFF, src, 64 * kb, (bf16_t*)(p.ws + WS_WUP + (size_t)l * WS_WL1), D, 32 * nb, p.in[9] + l * D, scr, lane); continue; }
        r -= n_up;
        { const int kb = r >> 5, nb = r & 31;
            transpose_item(p.in[13] + (size_t)l * DFF * D, D, 32 * nb, 64 * kb, (bf16_t*)(p.ws + WS_WDN + (size_t)l * WS_WL1), DFF, 32 * nb, nullptr, scr, lane); }
    }
}
__device__ __forceinline__ void gates_rows(const Params& p, int l, const float* SS, int gw, int NGW, int lane) {
    typedef short bf16x8g __attribute__((ext_vector_type(8)));
    const bf16_t* WGb = (const bf16_t*)(p.ws + WS_WG) + l * 16384; const bf16_t* XN = (const bf16_t*)(p.ws + WS_XN); float* G = (float*)(p.ws + WS_G); const float* bgt = p.in[3] + l * 8;
    const int fr = lane & 15, fq = lane >> 4;
    for (int rg = gw; rg < M / 16; rg += NGW) {
        const bf16_t* ap = XN + (size_t)(rg * 16 + fr) * D + 8 * fq; const bf16_t* bp = WGb + fr * D + 8 * fq;
        f32x4 acc = (f32x4){0.f, 0.f, 0.f, 0.f};
#pragma unroll 8
        for (int kt = 0; kt < 32; ++kt) acc = __builtin_amdgcn_mfma_f32_16x16x32_bf16(*(const bf16x8g*)(ap + 32 * kt), *(const bf16x8g*)(bp + 32 * kt), acc, 0, 0, 0);
        if (fr < 8) {
#pragma unroll
            for (int r = 0; r < 4; ++r) { const int tok = rg * 16 + 4 * fq + r; G[(size_t)tok * 8 + fr] = acc[r] * rsqrtf(ss_row(SS, tok) * (1.f / D) + EPS) + bgt[fr]; }
        }
    }
}

typedef short bf16x8v __attribute__((ext_vector_type(8)));
constexpr int PK = 72, PK2 = 136;
__device__ __forceinline__ bf16x8v ldfrag(const LAS bf16_t* base, int pitch, int row, int k0) { return *(const LAS bf16x8v*)(base + row * pitch + k0); }
__device__ __forceinline__ bf16x8v ldfrag_sw(const LAS bf16_t* base, int pitch, int row, int k0) { return *(const LAS bf16x8v*)(base + row * pitch + (k0 ^ (((row >> 3) & 7) << 3))); }
__device__ __forceinline__ bf16_t f2bf1(float x) { return (bf16_t)(pk_bf16(x, 0.f) & 0xffffu); }

__device__ __forceinline__ void conv8(const bf16_t* P, const float* wconv, int b, int c, int s, int col, float (&a)[8]) {
#pragma unroll
    for (int i = 0; i < 8; ++i) a[i] = 0.f;
#pragma unroll
    for (int j = 0; j < 4; ++j) {
        const int pos = c * CH + s - 3 + j;
        if (pos >= 0) {
            const u32x4 w = *(const u32x4*)(P + (size_t)(b * SEQ + pos) * NP + col);
            float x[8]; unpack8(w, x);
            const f32x4 c0 = *(const f32x4*)(wconv + j * 512 + col), c1 = *(const f32x4*)(wconv + j * 512 + col + 4);
            a[0] += c0[0] * x[0]; a[1] += c0[1] * x[1]; a[2] += c0[2] * x[2]; a[3] += c0[3] * x[3];
            a[4] += c1[0] * x[4]; a[5] += c1[1] * x[5]; a[6] += c1[2] * x[6]; a[7] += c1[3] * x[7];
        }
    }
#pragma unroll
    for (int i = 0; i < 8; ++i) a[i] = silu_fast(a[i]);
}
template <int NTU = 256>
__device__ __forceinline__ void load_vT(const bf16_t* P, int tok0, int h, LAS bf16_t* dst, int tid) {
    constexpr int NR = 1024 / NTU;
    u32x4 w[NR];
#pragma unroll
    for (int r = 0; r < NR; ++r) { const int id = tid + NTU * r, s = id >> 4, e8 = id & 15; w[r] = *(const u32x4*)(P + (size_t)(tok0 + s) * NP + 512 + h * DV + 8 * e8); }
#pragma unroll
    for (int r = 0; r < NR; ++r) { const int id = tid + NTU * r, s = id >> 4, e8 = id & 15;
        LAS bf16_t* d = dst + (8 * e8) * PK + (s ^ ((e8 & 7) << 3));
        d[0 * PK] = (bf16_t)(w[r].x & 0xffffu); d[1 * PK] = (bf16_t)(w[r].x >> 16); d[2 * PK] = (bf16_t)(w[r].y & 0xffffu); d[3 * PK] = (bf16_t)(w[r].y >> 16);
        d[4 * PK] = (bf16_t)(w[r].z & 0xffffu); d[5 * PK] = (bf16_t)(w[r].z >> 16); d[6 * PK] = (bf16_t)(w[r].w & 0xffffu); d[7 * PK] = (bf16_t)(w[r].w >> 16); }
}

constexpr int B1_LDS = 28672;
__device__ __forceinline__ void b1_chunk_unit(const Params& p, int l, int u, bool valid, LAS unsigned char* lds, int tid) {
    LAS bf16_t* kT = (LAS bf16_t*)lds; LAS bf16_t* vT = (LAS bf16_t*)(lds + 9216); LAS float* wl = (LAS float*)(lds + 27648);
    const bf16_t* P = (const bf16_t*)(p.ws + WS_P); const float* G = (const float*)(p.ws + WS_G);
    const int bh = u >> 6, c = u & 63, b = bh >> 2, h = bh & 3, tok0 = b * SEQ + c * CH, lane = tid & 63, w = tid >> 6, fr = lane & 15, fq = lane >> 4;
    if (tid < 64) {
        const float ig = G[(size_t)(tok0 + lane) * 8 + h], fg = G[(size_t)(tok0 + lane) * 8 + 4 + h];
        const float bc = wave_incl_sum(log_sigmoid(fg), lane);
        const float blast = shfl_idx(bc, 63);
        const float a = blast - bc + ig;
        const float mloc = wave_max(a, lane);
        wl[lane] = expf(a - mloc);
        if (lane == 0 && valid) { ((float*)(p.ws + WS_BL))[u] = blast; ((float*)(p.ws + WS_ML))[u] = mloc; }
    }
    bf16_t* QKC = (bf16_t*)(p.ws + WS_QKC);
#pragma unroll
    for (int rr = 0; rr < 4; ++rr) {
        const int id = tid + 128 * rr, s = id >> 3, dg = id & 7; float a[8];
        conv8(P, p.in[4] + l * 4 * 512, b, c, s, h * DK + 8 * dg, a);
        u32x4 o; o.x = pk_bf16(a[0], a[1]); o.y = pk_bf16(a[2], a[3]); o.z = pk_bf16(a[4], a[5]); o.w = pk_bf16(a[6], a[7]);
        if (valid) *(u32x4*)(QKC + (size_t)(tok0 + s) * 512 + h * DK + 8 * dg) = o;
    }
    __syncthreads();
#pragma unroll
    for (int rr = 0; rr < 4; ++rr) {
        const int id = tid + 128 * rr, s = id >> 3, dg = id & 7; float a[8];
        conv8(P, p.in[4] + l * 4 * 512, b, c, s, 256 + h * DK + 8 * dg, a);
#pragma unroll
        for (int i = 0; i < 8; ++i) a[i] *= 0.125f;
        u32x4 o; o.x = pk_bf16(a[0], a[1]); o.y = pk_bf16(a[2], a[3]); o.z = pk_bf16(a[4], a[5]); o.w = pk_bf16(a[6], a[7]);
        if (valid) *(u32x4*)(QKC + (size_t)(tok0 + s) * 512 + 256 + h * DK + 8 * dg) = o;
        const float ws_ = wl[s];
#pragma unroll
        for (int i = 0; i < 8; ++i) kT[(8 * dg + i) * PK + (s ^ (dg << 3))] = f2bf1(a[i] * ws_);
    }
    load_vT<128>(P, tok0, h, vT, tid);
    __syncthreads();
    bf16_t* CST = (bf16_t*)(p.ws + WS_CST) + (size_t)u * 8192;
#pragma unroll
    for (int e2 = 0; e2 < 4; ++e2) {
        const int et = 4 * w + e2;
        f32x4 acc[4];
#pragma unroll
        for (int i = 0; i < 4; ++i) acc[i] = (f32x4){0.f, 0.f, 0.f, 0.f};
#pragma unroll
        for (int kt = 0; kt < 2; ++kt) {
            const bf16x8v bf = ldfrag_sw(vT, PK, 16 * et + fr, 32 * kt + 8 * fq);
#pragma unroll
            for (int mt = 0; mt < 4; ++mt) acc[mt] = __builtin_amdgcn_mfma_f32_16x16x32_bf16(ldfrag_sw(kT, PK, 16 * mt + fr, 32 * kt + 8 * fq), bf, acc[mt], 0, 0, 0);
        }
        if (valid) {
#pragma unroll
            for (int mt = 0; mt < 4; ++mt) { u32x2 o; o.x = pk_bf16(acc[mt][0], acc[mt][1]); o.y = pk_bf16(acc[mt][2], acc[mt][3]); *(u32x2*)(CST + (16 * et + fr) * 64 + 16 * mt + 4 * fq) = o; }
        }
    }
    if (tid < 64) { float s = 0.f;
#pragma unroll
        for (int i = 0; i < 8; ++i) { const u32x4 q = *(const LAS u32x4*)(kT + tid * PK + 8 * i); float x[8]; unpack8(q, x); s += ((x[0] + x[1]) + (x[2] + x[3])) + ((x[4] + x[5]) + (x[6] + x[7])); }
        if (valid) ((float*)(p.ws + WS_NST))[(size_t)u * 64 + tid] = s; }
    __syncthreads();
}
template <int W>
__device__ __forceinline__ void pool_dm(const bf16_t* P, int tok0, int pos0, int g, LAS bf16_t* dm, int tid) {
    const int tg = tid >> 4, c8 = tid & 15, t0 = 8 * tg;
    const bf16_t* src = P + (size_t)(tok0 + t0) * NP + 1536 + g * 128 + 8 * c8;
    u32x4 raw[W + 7];
#pragma unroll
    for (int i = 0; i < W + 7; ++i) { const int rel = i - (W - 1); raw[i] = (pos0 + t0 + rel >= 0) ? *(const u32x4*)(src + (long)rel * NP) : (u32x4){0u, 0u, 0u, 0u}; }
    float sum[8];
#pragma unroll
    for (int k = 0; k < 8; ++k) sum[k] = 0.f;
#pragma unroll
    for (int i = 0; i < W - 1; ++i) { float x[8]; unpack8(raw[i], x);
#pragma unroll
        for (int k = 0; k < 8; ++k) sum[k] += x[k]; }
#pragma unroll
    for (int tt = 0; tt < 8; ++tt) {
        float cur[8]; unpack8(raw[tt + W - 1], cur);
#pragma unroll
        for (int k = 0; k < 8; ++k) sum[k] += cur[k];
        const int cnt = min(pos0 + t0 + tt + 1, W);
        const float inv = 1.f / (float)cnt;
        float o[8];
#pragma unroll
        for (int k = 0; k < 8; ++k) o[k] = sum[k] * inv - cur[k];
        u32x4 ov; ov.x = pk_bf16(o[0], o[1]); ov.y = pk_bf16(o[2], o[3]); ov.z = pk_bf16(o[4], o[5]); ov.w = pk_bf16(o[6], o[7]);
        *(LAS u32x4*)(dm + (t0 + tt) * PK2 + 8 * c8) = ov;
        float old[8]; unpack8(raw[tt], old);
#pragma unroll
        for (int k = 0; k < 8; ++k) sum[k] -= old[k];
    }
}
__device__ __forceinline__ void pool_unit(const Params& p, int l, int pu, LAS unsigned char* lds, int tid) {
    LAS bf16_t* wT = (LAS bf16_t*)lds; LAS bf16_t* dm = (LAS bf16_t*)(lds + 34816);
    const bf16_t* P = (const bf16_t*)(p.ws + WS_P); bf16_t* HC = (bf16_t*)(p.ws + WS_HCAT);
    const int tb = pu >> 2, g = pu & 3, tok0 = tb * 256, pos0 = tok0 & (SEQ - 1), lane = tid & 63, w = tid >> 6, fr = lane & 15, fq = lane >> 4;
    const bf16_t* wsrc = (const bf16_t*)(p.ws + WS_WPT) + ((size_t)l * 4 + g) * 128 * 128;
#pragma unroll
    for (int r = 0; r < 4; ++r) { const int id = tid + 512 * r, dc = id >> 4, c8 = id & 15; *(LAS u32x4*)(wT + dc * PK2 + 8 * c8) = *(const u32x4*)(wsrc + dc * 128 + 8 * c8); }
    if (g == 0) pool_dm<2>(P, tok0, pos0, g, dm, tid); else if (g == 1) pool_dm<4>(P, tok0, pos0, g, dm, tid); else if (g == 2) pool_dm<8>(P, tok0, pos0, g, dm, tid); else pool_dm<16>(P, tok0, pos0, g, dm, tid);
    __syncthreads();
    bf16x8v af[4];
#pragma unroll
    for (int kt = 0; kt < 4; ++kt) af[kt] = ldfrag(wT, PK2, 16 * w + fr, 32 * kt + 8 * fq);
    const f32x4 ps = *(const f32x4*)(p.in[7] + l * 512 + g * 128 + 16 * w + 4 * fq);
#pragma unroll 4
    for (int nt = 0; nt < 16; ++nt) {
        f32x4 acc = (f32x4){0.f, 0.f, 0.f, 0.f};
#pragma unroll
        for (int kt = 0; kt < 4; ++kt) acc = __builtin_amdgcn_mfma_f32_16x16x32_bf16(af[kt], ldfrag(dm, PK2, 16 * nt + fr, 32 * kt + 8 * fq), acc, 0, 0, 0);
        const f32x4 y = acc * ps; u32x2 o; o.x = pk_bf16(y[0], y[1]); o.y = pk_bf16(y[2], y[3]);
        *(u32x2*)(HC + (size_t)(tok0 + 16 * nt + fr) * D + 512 + g * 128 + 16 * w + 4 * fq) = o;
    }
    __syncthreads();
}
__device__ __forceinline__ void b2_scan_pool(const Params& p, int l, LAS unsigned char* lds, int bx, int G_, int tid) {
    const int grp = tid >> 8, tl = tid & 255, lane = tid & 63, w = tl >> 6, fr = lane & 15, fq = lane >> 4;
    LAS bf16_t* wT = (LAS bf16_t*)lds; LAS bf16_t* dm = (LAS bf16_t*)(lds + 34816);
    LAS float* s_sp = (LAS float*)(lds + 104448); LAS float* s_sl = s_sp + 64;
    const float* BL = (const float*)(p.ws + WS_BL); const float* ML = (const float*)(p.ws + WS_ML); float* MP = (float*)(p.ws + WS_MP);
    const bf16_t* P = (const bf16_t*)(p.ws + WS_P); bf16_t* HC = (bf16_t*)(p.ws + WS_HCAT);
    for (int it = bx; it < 256; it += G_) {
        unsigned cl[64];
        if (grp == 0) {
            int it0 = it; asm volatile("" : "+s"(it0)); const int bh = it0 >> 4, sub = it0 & 15;
            { const unsigned* q = (const unsigned*)((const bf16_t*)(p.ws + WS_CST) + (size_t)bh * 64 * 8192 + sub * 512 + 2 * tl);
              int stride0 = 4096; asm volatile("" : "+v"(stride0));
#pragma unroll
              for (int c = 0; c < 64; ++c) { cl[c] = __builtin_nontemporal_load(q); q += stride0; } }
            if (tl < 64) {
                const float gg = BL[bh * 64 + lane], ml = ML[bh * 64 + lane];
                float m = 0.f, mp = 0.f, mn_own = 0.f;
                for (int c = 0; c < 64; ++c) {
                    const float gc = __builtin_bit_cast(float, __builtin_amdgcn_readlane(__builtin_bit_cast(int, gg), c)), mlc = __builtin_bit_cast(float, __builtin_amdgcn_readlane(__builtin_bit_cast(int, ml), c));
                    const float mn = fmaxf(gc + m, mlc);
                    if (lane == c) { mp = m; mn_own = mn; }
                    m = mn;
                }
                s_sp[lane] = expf(gg + mp - mn_own); s_sl[lane] = expf(ml - mn_own);
                if (sub == 0) MP[bh * 64 + lane] = mp;
            }
        } else {
            int it1 = it; asm volatile("" : "+s"(it1)); const int tb = it1 >> 2, g = it1 & 3, tok0 = tb * 256, pos0 = tok0 & (SEQ - 1);
            const bf16_t* wsrc = (const bf16_t*)(p.ws + WS_WPT) + ((size_t)l * 4 + g) * 128 * 128;
#pragma unroll
            for (int r = 0; r < 8; ++r) { const int id = tl + 256 * r, dc = id >> 4, c8 = id & 15; *(LAS u32x4*)(wT + dc * PK2 + 8 * c8) = *(const u32x4*)(wsrc + dc * 128 + 8 * c8); }
#pragma unroll 1
            for (int r = 0; r < 2; ++r) { const int id = tl + 256 * r;
                if (g == 0) pool_dm<2>(P, tok0, pos0, g, dm, id); else if (g == 1) pool_dm<4>(P, tok0, pos0, g, dm, id); else if (g == 2) pool_dm<8>(P, tok0, pos0, g, dm, id); else pool_dm<16>(P, tok0, pos0, g, dm, id); }
        }
        __syncthreads();
        if (grp == 0) {
            int it0 = it; asm volatile("" : "+s"(it0)); const int bh = it0 >> 4, sub = it0 & 15;
            const LAS float* vsp = s_sp; const LAS float* vsl = s_sl; asm volatile("" : "+v"(vsp), "+v"(vsl));
            {
                const size_t off = (size_t)bh * 64 * 8192 + sub * 512 + 2 * tl;
                const unsigned* base = (const unsigned*)((const bf16_t*)(p.ws + WS_CST) + off); unsigned* ob = (unsigned*)((bf16_t*)(p.ws + WS_CPB) + off);
                int stride = 4096; asm volatile("" : "+v"(stride));
                float c0 = 0.f, c1 = 0.f;
                { unsigned* q = ob;
#pragma unroll
                  for (int c = 0; c < 64; ++c) { *q = pk_bf16(c0, c1); q += stride; const float sp = vsp[c], sl = vsl[c]; c0 = sp * c0 + sl * bf_lo(cl[c]); c1 = sp * c1 + sl * bf_hi(cl[c]); } }
            }
            if (sub == 0 && tl < 64) {
                float* base = (float*)(p.ws + WS_NST) + (size_t)bh * 64 * 64 + tl;
                float cl[64];
#pragma unroll
                for (int c = 0; c < 64; ++c) cl[c] = base[c * 64];
                float cs = 0.f;
#pragma unroll
                for (int c = 0; c < 64; ++c) { base[c * 64] = cs; cs = vsp[c] * cs + vsl[c] * cl[c]; }
            }
        } else {
            int it1 = it; asm volatile("" : "+s"(it1)); const int tb = it1 >> 2, g = it1 & 3, tok0 = tb * 256;
            bf16x8v af[2][4];
#pragma unroll
            for (int d2 = 0; d2 < 2; ++d2)
#pragma unroll
                for (int kt = 0; kt < 4; ++kt) af[d2][kt] = ldfrag(wT, PK2, 32 * w + 16 * d2 + fr, 32 * kt + 8 * fq);
            f32x4 ps[2];
#pragma unroll
            for (int d2 = 0; d2 < 2; ++d2) ps[d2] = *(const f32x4*)(p.in[7] + l * 512 + g * 128 + 32 * w + 16 * d2 + 4 * fq);
#pragma unroll 2
            for (int nt = 0; nt < 16; ++nt) {
                bf16x8v bd[4];
#pragma unroll
                for (int kt = 0; kt < 4; ++kt) bd[kt] = ldfrag(dm, PK2, 16 * nt + fr, 32 * kt + 8 * fq);
#pragma unroll
                for (int d2 = 0; d2 < 2; ++d2) {
                    f32x4 acc = (f32x4){0.f, 0.f, 0.f, 0.f};
#pragma unroll
                    for (int kt = 0; kt < 4; ++kt) acc = __builtin_amdgcn_mfma_f32_16x16x32_bf16(af[d2][kt], bd[kt], acc, 0, 0, 0);
                    const f32x4 y = acc * ps[d2]; u32x2 o; o.x = pk_bf16(y[0], y[1]); o.y = pk_bf16(y[2], y[3]);
                    *(u32x2*)(HC + (size_t)(tok0 + 16 * nt + fr) * D + 512 + g * 128 + 32 * w + 16 * d2 + 4 * fq) = o;
                }
            }
        }
        __syncthreads();
    }
}
constexpr int B3_LDS = 68608;
__device__ __forceinline__ void b3_chunk_unit(const Params& p, int l, int u, bool valid, LAS unsigned char* lds, int tid) {
    LAS bf16_t* qs = (LAS bf16_t*)lds; LAS bf16_t* ks = (LAS bf16_t*)(lds + 9216); LAS bf16_t* vT = (LAS bf16_t*)(lds + 18432); LAS bf16_t* cpT = (LAS bf16_t*)(lds + 36864);
    LAS bf16_t* Sb = (LAS bf16_t*)(lds + 55296); LAS float* sca = (LAS float*)(lds + 64512); LAS float* part = (LAS float*)(lds + 66048);
    LAS float* s_u = sca, * s_bm = sca + 64, * s_m = sca + 128, * s_sc = sca + 192, * s_np = sca + 256, * s_den = sca + 320;
    const bf16_t* P = (const bf16_t*)(p.ws + WS_P); const float* G = (const float*)(p.ws + WS_G); bf16_t* HC = (bf16_t*)(p.ws + WS_HCAT);
    const int bh = u >> 6, c = u & 63, b = bh >> 2, h = bh & 3, tok0 = b * SEQ + c * CH, lane = tid & 63, w = tid >> 6, fr = lane & 15, fq = lane >> 4;
    u32x2 ow[2][4]; f32x4 gh[2];
#pragma unroll
    for (int e2 = 0; e2 < 2; ++e2) { gh[e2] = *(const f32x4*)(p.in[5] + l * 512 + h * DV + 32 * w + 16 * e2 + 4 * fq);
#pragma unroll
        for (int nt = 0; nt < 4; ++nt) ow[e2][nt] = __builtin_nontemporal_load((const u32x2*)(P + (size_t)(tok0 + 16 * nt + fr) * NP + 1024 + h * DV + 32 * w + 16 * e2 + 4 * fq)); }
    if (tid < 64) {
        const float ig = G[(size_t)(tok0 + lane) * 8 + h], fg = G[(size_t)(tok0 + lane) * 8 + 4 + h];
        const float bc = wave_incl_sum(log_sigmoid(fg), lane);
        const float uu = ig - bc;
        const float pm = wave_incl_max(uu, lane);
        const float mprev = ((const float*)(p.ws + WS_MP))[u];
        const float minter = bc + mprev;
        const float mm = fmaxf(minter, bc + pm);
        s_u[lane] = uu; s_bm[lane] = bc - mm; s_m[lane] = mm; s_sc[lane] = expf(minter - mm);
        s_np[lane] = ((const float*)(p.ws + WS_NST))[(size_t)u * 64 + lane];
    }
    { const bf16_t* CPB = (const bf16_t*)(p.ws + WS_CPB) + (size_t)u * 8192;
      u32x4 t[4];
#pragma unroll
      for (int r = 0; r < 4; ++r) { const int id = tid + 256 * r, e = id >> 3, d8 = id & 7; t[r] = __builtin_nontemporal_load((const u32x4*)(CPB + e * 64 + 8 * d8)); }
#pragma unroll
      for (int r = 0; r < 4; ++r) { const int id = tid + 256 * r, e = id >> 3, d8 = id & 7; *(LAS u32x4*)(cpT + e * PK + 8 * d8) = t[r]; } }
    load_vT(P, tok0, h, vT, tid);
    { const bf16_t* QKC = (const bf16_t*)(p.ws + WS_QKC); u32x4 tq[2], tk[2];
#pragma unroll
      for (int rr = 0; rr < 2; ++rr) { const int id = tid + 256 * rr, s = id >> 3, dg = id & 7;
          tq[rr] = __builtin_nontemporal_load((const u32x4*)(QKC + (size_t)(tok0 + s) * 512 + h * DK + 8 * dg)); tk[rr] = __builtin_nontemporal_load((const u32x4*)(QKC + (size_t)(tok0 + s) * 512 + 256 + h * DK + 8 * dg)); }
#pragma unroll
      for (int rr = 0; rr < 2; ++rr) { const int id = tid + 256 * rr, s = id >> 3, dg = id & 7;
          *(LAS u32x4*)(qs + s * PK + 8 * dg) = tq[rr]; *(LAS u32x4*)(ks + s * PK + 8 * dg) = tk[rr]; } }
    __syncthreads();
    {
        const int mt = w;
#pragma unroll
        for (int nt = 0; nt < 4; ++nt) {
            f32x4 acc = (f32x4){0.f, 0.f, 0.f, 0.f};
            if (mt <= nt) {
#pragma unroll
                for (int kt = 0; kt < 2; ++kt) acc = __builtin_amdgcn_mfma_f32_16x16x32_bf16(ldfrag(ks, PK, 16 * mt + fr, 32 * kt + 8 * fq), ldfrag(qs, PK, 16 * nt + fr, 32 * kt + 8 * fq), acc, 0, 0, 0);
            }
            const int j = 16 * nt + fr; const float bm = s_bm[j]; float o[4];
#pragma unroll
            for (int r = 0; r < 4; ++r) { const int s = 16 * mt + 4 * fq + r; o[r] = (s <= j) ? acc[r] * exp_fast(bm + s_u[s]) : 0.f; }
            u32x2 ov; ov.x = pk_bf16(o[0], o[1]); ov.y = pk_bf16(o[2], o[3]);
            *(LAS u32x2*)(Sb + j * PK + 16 * mt + 4 * fq) = ov;
        }
    }
    __syncthreads();
    if (tid < 64) {
        float s1 = 0.f, s2 = 0.f;
#pragma unroll
        for (int i = 0; i < 8; ++i) { const u32x4 a = *(const LAS u32x4*)(Sb + tid * PK + 8 * i), qv = *(const LAS u32x4*)(qs + tid * PK + 8 * i); float x[8], y[8]; unpack8(a, x); unpack8(qv, y);
#pragma unroll
            for (int k = 0; k < 8; ++k) { s1 += x[k]; s2 += y[k] * s_np[8 * i + k]; } }
        s_den[tid] = s1 + s_sc[tid] * s2;
    }
    f32x4 a1[2][4], a2[2][4];
#pragma unroll
    for (int e2 = 0; e2 < 2; ++e2)
#pragma unroll
        for (int nt = 0; nt < 4; ++nt) { a1[e2][nt] = (f32x4){0.f, 0.f, 0.f, 0.f}; a2[e2][nt] = (f32x4){0.f, 0.f, 0.f, 0.f}; }
#pragma unroll
    for (int kt = 0; kt < 2; ++kt) {
        bf16x8v bs[4], bq[4];
#pragma unroll
        for (int nt = 0; nt < 4; ++nt) { bs[nt] = ldfrag(Sb, PK, 16 * nt + fr, 32 * kt + 8 * fq); bq[nt] = ldfrag(qs, PK, 16 * nt + fr, 32 * kt + 8 * fq); }
#pragma unroll
        for (int e2 = 0; e2 < 2; ++e2) {
            const bf16x8v av = ldfrag_sw(vT, PK, 32 * w + 16 * e2 + fr, 32 * kt + 8 * fq), ac = ldfrag(cpT, PK, 32 * w + 16 * e2 + fr, 32 * kt + 8 * fq);
#pragma unroll
            for (int nt = 0; nt < 4; ++nt) {
                a1[e2][nt] = __builtin_amdgcn_mfma_f32_16x16x32_bf16(av, bs[nt], a1[e2][nt], 0, 0, 0);
                a2[e2][nt] = __builtin_amdgcn_mfma_f32_16x16x32_bf16(ac, bq[nt], a2[e2][nt], 0, 0, 0);
            }
        }
    }
    __syncthreads();
#pragma unroll
    for (int nt = 0; nt < 4; ++nt) {
        const int j = 16 * nt + fr; const float sc = s_sc[j];
        const float dn = __builtin_amdgcn_rcpf(fmaxf(fabsf(s_den[j]), exp_fast(-s_m[j])));
        float ssq = 0.f;
#pragma unroll
        for (int e2 = 0; e2 < 2; ++e2) { a1[e2][nt] = (a1[e2][nt] + sc * a2[e2][nt]) * dn;
            ssq += (a1[e2][nt][0] * a1[e2][nt][0] + a1[e2][nt][1] * a1[e2][nt][1]) + (a1[e2][nt][2] * a1[e2][nt][2] + a1[e2][nt][3] * a1[e2][nt][3]); }
        ssq += shfl_idx(ssq, lane ^ 16); ssq += shfl_idx(ssq, lane ^ 32);
        if (fq == 0) part[w * 64 + j] = ssq;
    }
    __syncthreads();
#pragma unroll
    for (int nt = 0; nt < 4; ++nt) {
        const int j = 16 * nt + fr;
        const float tot = (part[j] + part[64 + j]) + (part[128 + j] + part[192 + j]);
        const float rn = rsqrtf(tot * (1.f / DV) + EPS);
#pragma unroll
        for (int e2 = 0; e2 < 2; ++e2) {
            const f32x4 hv = a1[e2][nt]; const u32x2 o = ow[e2][nt]; const f32x4 g4 = gh[e2];
            const f32x4 y = (f32x4){hv[0] * rn * g4[0] * sigmoid_fast(bf_lo(o.x)), hv[1] * rn * g4[1] * sigmoid_fast(bf_hi(o.x)), hv[2] * rn * g4[2] * sigmoid_fast(bf_lo(o.y)), hv[3] * rn * g4[3] * sigmoid_fast(bf_hi(o.y))};
            u32x2 o2; o2.x = pk_bf16(y[0], y[1]); o2.y = pk_bf16(y[2], y[3]);
            if (valid) *(u32x2*)(HC + (size_t)(tok0 + j) * D + h * DV + 32 * w + 16 * e2 + 4 * fq) = o2;
        }
    }
    __syncthreads();
}
__device__ __forceinline__ void ffn_fixup_tile(const Params& p, int l, int pm, int tid) {
    const float* HEAD = (const float*)(p.ws + WS_HEAD); const float* TAIL = (const float*)(p.ws + WS_TAIL); bf16_t* ACT = (bf16_t*)(p.ws + WS_ACT);
    const float* cw = p.in[11] + (size_t)l * 3 * 2 * DFF; const float* cb = p.in[12] + (size_t)l * 2 * DFF;
    const bool first = (pm & 15) == 0;
    for (int id = tid; id < 2 * (DFF / 4); id += NT) {
        const int t = id / (DFF / 4), c = 4 * (id % (DFF / 4));
        f32x4 o[2];
#pragma unroll
        for (int gv = 0; gv < 2; ++gv) {
            const int cc = gv * DFF + c; const f32x4 z = (f32x4){0.f, 0.f, 0.f, 0.f};
            const f32x4 t0 = first ? z : *(const f32x4*)(TAIL + ((size_t)(pm - 1) * 2 + 0) * (2 * DFF) + cc), t1 = first ? z : *(const f32x4*)(TAIL + ((size_t)(pm - 1) * 2 + 1) * (2 * DFF) + cc);
            const f32x4 h0 = *(const f32x4*)(HEAD + ((size_t)pm * 2 + 0) * (2 * DFF) + cc), h1 = *(const f32x4*)(HEAD + ((size_t)pm * 2 + 1) * (2 * DFF) + cc);
            const f32x4 x2 = t ? t1 : t0, x1 = t ? h0 : t1, x0 = t ? h1 : h0;
            o[gv] = *(const f32x4*)(cw + cc) * x2 + *(const f32x4*)(cw + 2 * DFF + cc) * x1 + *(const f32x4*)(cw + 4 * DFF + cc) * x0 + *(const f32x4*)(cb + cc);
        }
        u32x2 w; w.x = pk_bf16(silu_fast(o[0][0]) * o[1][0], silu_fast(o[0][1]) * o[1][1]); w.y = pk_bf16(silu_fast(o[0][2]) * o[1][2], silu_fast(o[0][3]) * o[1][3]);
        *(u32x2*)(ACT + (size_t)(pm * 256 + t) * DFF + c) = w;
    }
}
__device__ __forceinline__ void ffn_fixup(const Params& p, int l, int gt, int GT) {
    const float* HEAD = (const float*)(p.ws + WS_HEAD); const float* TAIL = (const float*)(p.ws + WS_TAIL); bf16_t* ACT = (bf16_t*)(p.ws + WS_ACT);
    const float* cw = p.in[11] + (size_t)l * 3 * 2 * DFF; const float* cb = p.in[12] + (size_t)l * 2 * DFF;
    for (int i = gt; i < 64 * 2 * DFF; i += GT) {
        const int pm = i / (2 * DFF), r = i % (2 * DFF), t = r / DFF, c = r % DFF;
        float o[2];
#pragma unroll
        for (int gv = 0; gv < 2; ++gv) {
            const int cc = gv * DFF + c;
            const bool first = (pm & 15) == 0;
            const float t0 = first ? 0.f : TAIL[((size_t)(pm - 1) * 2 + 0) * (2 * DFF) + cc], t1 = first ? 0.f : TAIL[((size_t)(pm - 1) * 2 + 1) * (2 * DFF) + cc];
            const float h0 = HEAD[((size_t)pm * 2 + 0) * (2 * DFF) + cc], h1 = HEAD[((size_t)pm * 2 + 1) * (2 * DFF) + cc];
            const float x2 = t ? t1 : t0, x1 = t ? h0 : t1, x0 = t ? h1 : h0;
            o[gv] = cw[cc] * x2 + cw[2 * DFF + cc] * x1 + cw[4 * DFF + cc] * x0 + cb[cc];
        }
        const float a = silu_f(o[0]) * o[1];
        ACT[(size_t)(pm * 256 + t) * DFF + c] = (bf16_t)(pk_bf16(a, 0.f) & 0xffffu);
    }
}

#define XB_TMO      128
#define XB_XCNT(j)  (256  + 64 * (j))
#define XB_XSUB(j)  (1280 + 64 * (j))
#define XB_XGEN(j)  (2304 + 64 * (j))
#define XB_TOP      3328
#define XB_TOPGEN   3392
#define XCD_BAR_WORDS 3456
#define XB_SPIN_CAP (1u << 18)

__device__ __forceinline__ unsigned xb_ld(unsigned* p)              { return __hip_atomic_load(p, __ATOMIC_RELAXED, __HIP_MEMORY_SCOPE_AGENT); }
__device__ __forceinline__ unsigned xb_add(unsigned* p, unsigned v) { return __hip_atomic_fetch_add(p, v, __ATOMIC_RELAXED, __HIP_MEMORY_SCOPE_AGENT); }
__device__ __forceinline__ unsigned xb_xcc_id() { return (unsigned)__builtin_amdgcn_s_getreg((3 << 11) | 20) & 0xFu; }
#define XB_SPIN(cond, bar) do { unsigned _sp = 0; while (cond) { __builtin_amdgcn_s_sleep(1); \
    if ((++_sp & 255u) == 0u) { if (xb_ld(&(bar)[XB_TMO])) break; if (_sp > XB_SPIN_CAP) { atomicAdd(&(bar)[XB_TMO], 1u); break; } } } } while (0)

struct XcdBarrier {
    unsigned* bar; unsigned x;
    volatile LAS unsigned* st;
};

__device__ __forceinline__ XcdBarrier xcd_barrier_post(unsigned* bar, volatile LAS unsigned* st) {
    XcdBarrier b; b.bar = bar; b.x = xb_xcc_id(); b.st = st;
    if (threadIdx.x == 0) (void)xb_add(&bar[XB_XCNT(b.x)], 1u);
    return b;
}
__device__ __forceinline__ void xcd_barrier_complete(unsigned* bar, unsigned x, unsigned& nloc, unsigned& nx) {
    const unsigned G = gridDim.x * gridDim.y * gridDim.z;
    unsigned sum, cnt, mine, sp = 0u;
    for (;;) {
        sum = 0u; cnt = 0u; mine = 0u;
#pragma unroll
        for (unsigned j = 0; j < 16; ++j) { const unsigned c = xb_ld(&bar[XB_XCNT(j)]); sum += c; cnt += (c > 0u) ? 1u : 0u; mine = (j == x) ? c : mine; }
        if (sum == G) break;
        __builtin_amdgcn_s_sleep(1);
        if ((++sp & 255u) == 0u) { if (xb_ld(&bar[XB_TMO])) break; if (sp > XB_SPIN_CAP) { atomicAdd(&bar[XB_TMO], 1u); break; } }
    }
    nloc = mine > 0u ? mine : 1u; nx = cnt > 0u ? cnt : 1u;
}

__device__ __forceinline__ void xcd_barrier(const XcdBarrier& b, int wave0) {
    int l0_; asm volatile("v_mbcnt_lo_u32_b32 %0, -1, 0\n\tv_mbcnt_hi_u32_b32 %0, -1, %0" : "=v"(l0_));
    const bool leader_ = (wave0 == 0) && (l0_ == 0);
    asm volatile("s_waitcnt vmcnt(0)" ::: "memory");
    __syncthreads();
    if (leader_) {
        unsigned* bar = b.bar;
        __builtin_amdgcn_s_waitcnt(0);
        unsigned nloc = b.st[0], nx = b.st[1];
        if (nloc == 0u) { xcd_barrier_complete(bar, b.x, nloc, nx); b.st[0] = nloc; b.st[1] = nx; }
        const unsigned old = xb_add(&bar[XB_XSUB(b.x)], 1u);
        const unsigned gen = old / nloc;
        if (old + 1u == (gen + 1u) * nloc) {
            __builtin_amdgcn_fence(__ATOMIC_RELEASE, "agent");
            asm volatile("s_waitcnt vmcnt(0)" ::: "memory");
            const unsigned og = xb_add(&bar[XB_TOP], 1u);
            const unsigned tg = og / nx;
            if (og + 1u == (tg + 1u) * nx) xb_add(&bar[XB_TOPGEN], 1u);
            else XB_SPIN(xb_ld(&bar[XB_TOPGEN]) == tg, bar);
            __builtin_amdgcn_fence(__ATOMIC_ACQUIRE, "agent");
            xb_add(&bar[XB_XGEN(b.x)], 1u);
            asm volatile("s_waitcnt vmcnt(0)" ::: "memory");
        } else {
            XB_SPIN(xb_ld(&bar[XB_XGEN(b.x)]) == gen, bar);
            __builtin_amdgcn_fence(__ATOMIC_ACQUIRE, "agent");
            asm volatile("s_waitcnt vmcnt(0)" ::: "memory");
        }
    }
    __syncthreads();
}


typedef const __attribute__((address_space(4))) Params* KernargP;
#define PHASE_BEGIN() KernargP kp_ = (KernargP)__builtin_amdgcn_kernarg_segment_ptr(); asm volatile("" : "+s"(kp_)); const Params& p = *(const Params*)kp_; \
    int lane_; asm volatile("v_mbcnt_lo_u32_b32 %0, -1, 0\n\tv_mbcnt_hi_u32_b32 %0, -1, %0" : "=v"(lane_)); const int wave_ = wave0; const int tid_ = wave_ * 64 + lane_; \
    const int G_ = gridDim.x, bx = blockIdx.x; const int gw_ = bx * NWAVES + wave_, NGW = G_ * NWAVES, gt_ = bx * NT + tid_, GT = G_ * NT; \
    LAS float* scr_ = (LAS float*)(lds + wave_ * 16384); float* SSb = (float*)(p.ws + WS_SS); bf16_t* XN = (bf16_t*)(p.ws + WS_XN); \
    (void)lane_; (void)gw_; (void)NGW; (void)gt_; (void)GT; (void)scr_; (void)SSb; (void)XN;
#define GRID_BAR() do { KernargP kb_ = (KernargP)__builtin_amdgcn_kernarg_segment_ptr(); asm volatile("" : "+s"(kb_)); XcdBarrier b_; b_.bar = (unsigned*)(((const Params*)kb_)->ws + WS_CTL); b_.x = xb_xcc_id(); \
    b_.st = (volatile LAS unsigned*)(lds + MISC_OFF); xcd_barrier(b_, wave0); } while (0)
template <int l>
__device__ __forceinline__ void layer_body(LAS unsigned char* lds, const int wave0) {
        { PHASE_BEGIN(); const float* SSmix = SSb + (size_t)(2 * l) * 4 * M;
          { pg8::Gemm g{XN, (const bf16_t*)(p.ws + WS_WIN + (size_t)l * WS_WL1), M, NP, D}; pg8::StaticOrder S; S.init(M, NP, G_, bx);
            EpiIn E{(bf16_t*)(p.ws + WS_P), SSmix};
            pg8::gemm_phase<EpiIn, pg8::StaticOrder, false, true>(lds, g, S, E, tid_); }
        }
        { PHASE_BEGIN(); gates_rows(p, l, SSb + (size_t)(2 * l) * 4 * M, gw_, NGW, lane_); }
        GRID_BAR();
        { PHASE_BEGIN(); const int grp = wave_ >> 1, tl = tid_ & 127;
          for (int i = 0; ; ++i) { if (bx + 4 * i * G_ >= NUNIT) break; int u = bx + (4 * i + grp) * G_; const bool valid = u < NUNIT; if (!valid) u = NUNIT - 1;
              b1_chunk_unit(p, l, u, valid, lds + grp * B1_LDS, tl); }
        }
        GRID_BAR();
        { PHASE_BEGIN(); b2_scan_pool(p, l, lds, bx, G_, tid_); }
        GRID_BAR();
        { PHASE_BEGIN(); const int grp = wave_ >> 2, tl = tid_ & 255;
          for (int i = 0; ; ++i) { if (bx + 2 * i * G_ >= NUNIT) break; int u = bx + (2 * i + grp) * G_; const bool valid = u < NUNIT; if (!valid) u = NUNIT - 1;
              b3_chunk_unit(p, l, u, valid, lds + grp * B3_LDS, tl); } }
        GRID_BAR();
        { PHASE_BEGIN();
          pg8::Gemm g{(const bf16_t*)(p.ws + WS_HCAT), (const bf16_t*)(p.ws + WS_WOUT + (size_t)l * WS_WL1), M, D, D}; pg8::StaticOrder S; S.init(M, D, G_, bx);
          EpiRes E{XN, SSb + (size_t)(2 * l + 1) * 4 * M};
          pg8::gemm_phase<EpiRes, pg8::StaticOrder, true, true>(lds, g, S, E, tid_); }
        GRID_BAR();
        { PHASE_BEGIN();
          pg8::Gemm g{XN, (const bf16_t*)(p.ws + WS_WUP + (size_t)l * WS_WL1), M, 2 * DFF, D}; pg8::StaticOrder S; S.init(M, 2 * DFF, G_, bx, 4);
          { const float* SSn = SSb + (size_t)(2 * l + 1) * 4 * M; LAS float* rsT = (LAS float*)(lds + RST_OFF);
            for (int i = 0; i < 6; ++i) { pg8::Unit uu; if (!S.next(i, uu)) break; if (tid_ < 256) rsT[i * 256 + tid_] = rsqrtf(ss_row(SSn, uu.pm * 256 + tid_) * (1.f / D) + EPS); }
            __syncthreads(); }
          EpiUp E{(bf16_t*)(p.ws + WS_ACT), SSb + (size_t)(2 * l + 1) * 4 * M, p.in[11] + (size_t)l * 3 * 2 * DFF, p.in[12] + (size_t)l * 2 * DFF, (float*)(p.ws + WS_HEAD), (float*)(p.ws + WS_TAIL)};
          pg8::gemm_phase<EpiUp, pg8::StaticOrder, true, true>(lds, g, S, E, tid_);
          { const int NU = 64 * 22, nmax = (NU + G_ - 1) / G_, b0 = NU - (nmax - 1) * G_;
            int ib = bx - b0, nb = G_ - b0; if (nb <= 0) { ib = bx; nb = G_; }
            if (ib >= 0) { const int cgw = ib * NWAVES + wave_, cng = nb * NWAVES;
                if (l == 0) { convert_weights(p, 0, 8, cgw, cng, scr_, lane_); convert_weights(p, 1, 7, cgw, cng, scr_, lane_); }
                else convert_weights(p, 1, 8, cgw, cng, scr_, lane_); } } }
        GRID_BAR();
        { PHASE_BEGIN();
          pg8::Gemm g{(const bf16_t*)(p.ws + WS_ACT), (const bf16_t*)(p.ws + WS_WDN + (size_t)l * WS_WL1), M, D, DFF}; pg8::StaticOrder S; S.init(M, D, G_, bx);
          EpiRes E{XN, SSb + (size_t)(2 * l + 2) * 4 * M};
          { pg8::Unit uu; for (int i = 0; S.next(i, uu); ++i) ffn_fixup_tile(p, l, uu.pm, tid_);
            asm volatile("s_waitcnt vmcnt(0)" ::: "memory"); __syncthreads(); }
          if (l == 1 && G_ == 256) { EpiFinal EF{XN, p.out, p.in[14], (float*)(p.ws + WS_FSLOT), (unsigned*)(p.ws + WS_FCNT)};
              pg8::gemm_phase<EpiFinal, pg8::StaticOrder, true, true>(lds, g, S, EF, tid_); }
          else pg8::gemm_phase<EpiRes, pg8::StaticOrder, true, true>(lds, g, S, E, tid_); }
        if (!(l == 1 && gridDim.x == 256)) GRID_BAR();
}

__global__ void __launch_bounds__(NT, 2) hymba_fwd(Params p_arg) {
    extern __shared__ __attribute__((aligned(16))) unsigned char lds_raw[];
    cg::grid_group grid = cg::this_grid();
    LAS unsigned char* lds = (LAS unsigned char*)lds_raw;
    const int wave0 = __builtin_amdgcn_readfirstlane((int)threadIdx.x >> 6);
    if (threadIdx.x < 2) ((volatile LAS unsigned*)(lds + MISC_OFF))[threadIdx.x] = 0u;
    __syncthreads();
    (void)xcd_barrier_post((unsigned*)(p_arg.ws + WS_CTL), (volatile LAS unsigned*)(lds + MISC_OFF));
    if (p_arg.ws == nullptr) grid.sync();

    { PHASE_BEGIN();
      convert_weights(p, 0, 7, gw_, NGW, scr_, lane_);
      for (int i = gt_; i < 2 * 16384; i += GT) { const int l = i >> 14, j = (i >> 10) & 15, k = i & 1023; ((bf16_t*)(p.ws + WS_WG))[i] = (j < 8) ? f2bf1(p.in[2][(size_t)l * D * INW + (size_t)k * INW + 1536 + j] * p.in[1][l * D + k]) : (bf16_t)0; }
      for (int i = gt_; i < 2 * 4 * 128 * 128; i += GT) { const int c = i & 127, dc = (i >> 7) & 127, lg = i >> 14; ((bf16_t*)(p.ws + WS_WPT))[i] = f2bf1(p.in[6][(size_t)lg * 16384 + c * 128 + dc]); }
      for (int m0 = gw_ * 4; m0 < M; m0 += NGW * 4) {
          f32x4 v[4][4];
#pragma unroll
          for (int r = 0; r < 4; ++r)
#pragma unroll
              for (int j = 0; j < 4; ++j) v[r][j] = __builtin_nontemporal_load((const f32x4*)(p.in[0] + (size_t)(m0 + r) * D) + lane_ + 64 * j);
#pragma unroll
          for (int r = 0; r < 4; ++r) { float s = 0.f;
#pragma unroll
              for (int j = 0; j < 4; ++j) { const f32x4 x = v[r][j]; s += (x[0] * x[0] + x[1] * x[1]) + (x[2] * x[2] + x[3] * x[3]);
                  u32x2 o; o.x = pk_bf16(x[0], x[1]); o.y = pk_bf16(x[2], x[3]); *((u32x2*)(XN + (size_t)(m0 + r) * D) + lane_ + 64 * j) = o; }
              s = wave_sum(s, lane_); if (lane_ == 0) *(f32x4*)(SSb + (size_t)(m0 + r) * 4) = (f32x4){s, 0.f, 0.f, 0.f}; }
      } }
    GRID_BAR();

    layer_body<0>(lds, wave0);
    layer_body<1>(lds, wave0);
    if (gridDim.x != 256) { PHASE_BEGIN(); const float* SSf = SSb + (size_t)4 * 4 * M; const float* gf = p.in[14];
      f32x4 gg[4];
#pragma unroll
      for (int j = 0; j < 4; ++j) gg[j] = *((const f32x4*)gf + lane_ + 64 * j);
      for (int m0 = gw_ * 4; m0 < M; m0 += NGW * 4) {
          u32x2 v[4][4]; float rs[4];
#pragma unroll
          for (int r = 0; r < 4; ++r) { rs[r] = ss_row(SSf, m0 + r);
#pragma unroll
              for (int j = 0; j < 4; ++j) v[r][j] = __builtin_nontemporal_load((const u32x2*)(XN + (size_t)(m0 + r) * D) + lane_ + 64 * j); }
#pragma unroll
          for (int r = 0; r < 4; ++r) { const float sc = rsqrtf(rs[r] * (1.f / D) + EPS);
#pragma unroll
              for (int j = 0; j < 4; ++j) { const f32x4 x = (f32x4){bf_lo(v[r][j].x), bf_hi(v[r][j].x), bf_lo(v[r][j].y), bf_hi(v[r][j].y)};
                  __builtin_nontemporal_store(x * sc * gg[j], (f32x4*)(p.out + (size_t)(m0 + r) * D) + lane_ + 64 * j); } }
      } }
}

extern "C" void kernel_launch(void* const* d_in, const int* in_sizes, int n_in, void* d_out, int out_size, void* d_ws, size_t ws_size, hipStream_t stream) {
    static int grid = 0;
    if (grid == 0) {
        if (n_in != 15 || in_sizes[0] != M * D || out_size != M * D || ws_size < WS_END) { fprintf(stderr, "kernel_launch: unexpected shapes (n_in %d, in0 %d, out %d, ws %zu)\n", n_in, n_in > 0 ? in_sizes[0] : -1, out_size, ws_size); grid = -1; return; }
        int dev = 0, cus = 0, per_cu = 0;
        if (hipGetDevice(&dev) != hipSuccess || hipDeviceGetAttribute(&cus, hipDeviceAttributeMultiprocessorCount, dev) != hipSuccess) { grid = -1; return; }
        if (hipFuncSetAttribute((const void*)hymba_fwd, hipFuncAttributeMaxDynamicSharedMemorySize, LDS_BYTES) != hipSuccess) { fprintf(stderr, "kernel_launch: hipFuncSetAttribute failed\n"); grid = -1; return; }
        if (hipOccupancyMaxActiveBlocksPerMultiprocessor(&per_cu, (const void*)hymba_fwd, NT, LDS_BYTES) != hipSuccess || per_cu < 1) { fprintf(stderr, "kernel_launch: occupancy query says %d blocks per CU\n", per_cu); per_cu = 1; }
        (void)hipGetLastError();
        grid = cus * per_cu;
    }
    if (grid < 0) return;
    if (hipMemsetAsync((char*)d_ws + WS_CTL, 0, 32768, stream) != hipSuccess) { fprintf(stderr, "kernel_launch: memset failed\n"); return; }
    Params p{};
    for (int i = 0; i < 15; ++i) p.in[i] = (const float*)d_in[i];
    p.out = (float*)d_out; p.ws = (unsigned char*)d_ws;
    void* args[] = {&p};
    hipError_t e = hipLaunchCooperativeKernel((const void*)hymba_fwd, dim3(grid), dim3(NT), args, LDS_BYTES, stream);
    if (e != hipSuccess) fprintf(stderr, "kernel_launch: cooperative launch failed: %s (grid %d)\n", hipGetErrorString(e), grid);
}
```

```cpp
#include <hip/hip_runtime.h>
#include <hip/hip_cooperative_groups.h>
#include <cstdio>
#include <cstdint>
namespace cg = cooperative_groups;
namespace pg8 {
#define PG8_LAS __attribute__((address_space(3)))
typedef unsigned short bf16_t;
typedef short bf16x8 __attribute__((ext_vector_type(8)));
typedef float f32x4 __attribute__((ext_vector_type(4)));
typedef unsigned u32x4 __attribute__((ext_vector_type(4)));
constexpr int BM = 256, BK = 64, HALF = 128, HTB = HALF * BK * 2  , STAGE_BYTES = 8 * HTB, NXCD = 8;

__host__ __device__ __forceinline__ int lds_byte(int r, int c) { const int st = (r >> 4) * 2 + (c >> 5), rr = r & 15, cc = c & 31, ob = rr * 64 + cc * 2; return st * 1024 + (ob ^ (((ob >> 9) & 1) << 5)); }
__host__ __device__ __forceinline__ void stage_rc(int b, int& R, int& C) { const int st = b / 1024, sb = b % 1024, swz = sb ^ (((sb >> 9) & 1) << 5); R = (st >> 1) * 16 + swz / 64; C = (st & 1) * 32 + (swz % 64) / 2; }
__host__ __device__ __forceinline__ int perm32(int rho) { const int n = rho >> 4, i = rho & 15; return 8 * (i >> 2) + 4 * n + (i & 3); }

struct Unit { int pm, pn; };
struct Gemm { const bf16_t* A; const bf16_t* Bt; int M, N, K; };

struct StaticOrder {
    int nM, nN, nwg, G, c, WGM;
    __host__ __device__ void init(int M, int N, int G_, int c_, int wgm = 4) { nM = M / BM; nN = N / BM; nwg = nM * nN; G = G_; c = c_; WGM = wgm; }
    __host__ __device__ bool next(int i, Unit& u) const {
        const long L = (long)i * G + c; if (L >= nwg) return false;
        int wgid = (int)L; { const int q = nwg / NXCD, r = nwg % NXCD, xcd = wgid % NXCD, off = wgid / NXCD; wgid = (xcd < r ? xcd * (q + 1) : r * (q + 1) + (xcd - r) * q) + off; }
        const int nig = WGM * nN, gid = wgid / nig, fm = gid * WGM, gsz = (nM - fm) < WGM ? (nM - fm) : WGM;
        u.pm = fm + ((wgid % nig) % gsz); u.pn = (wgid % nig) / gsz; return true;
    }
    __device__ __forceinline__ void a_ready(const Unit&) const {}
    __device__ __forceinline__ void done(const Unit&) const {}
};
template <class Epi, class Sched, bool ALIGN_EPI = false, bool SP2 = false>
__device__ __forceinline__ void gemm_phase(PG8_LAS unsigned char* lds, const Gemm g, const Sched& S, const Epi& E, int tid) {
    asm volatile("" : "+v"(tid));
    const int wid = __builtin_amdgcn_readfirstlane(tid >> 6), lane = tid & 63, wr = wid >> 2, wc = wid & 3, fr = lane & 15, fq = lane >> 4;
    const int K = g.K, nt = K / BK;
    unsigned voffA[2], voffB[2];
#pragma unroll
    for (int i = 0; i < 2; ++i) { int R, C; stage_rc(tid * 16 + i * 8192, R, C); const int Rb = Epi::PERM ? ((R & ~31) + perm32(R & 31)) : R;
        const int Ra = Epi::ROWPERM ? ((((R >> 6) * 16 + (R & 15)) * 8) + ((R >> 4) & 3)) : R;
        voffA[i] = (unsigned)(Ra * K + C) * 2u; voffB[i] = (unsigned)(Rb * K + C) * 2u; }
    const size_t kstep = (size_t)(BK * 2);
    const size_t hstepB = (size_t)HALF * K * 2;
    const size_t hstepA = Epi::ROWPERM ? (size_t)4 * K * 2 : hstepB;
    const size_t tstep = 2 * hstepB;
    const unsigned ldsw = (unsigned)wid * 1024u;
    const int aoff = lds_byte(wr * 64 + fr, fq * 8), boff = lds_byte(wc * 32 + fr, fq * 8);
#define PG8_SA(b, h) (((b) * 2 + (h)) * HTB)
#define PG8_SB(b, h) ((4 + (b) * 2 + (h)) * HTB)
#define PG8_STAGE(bufoff, gbase, voff) do { _Pragma("unroll") for (int _i = 0; _i < 2; ++_i) \
        __builtin_amdgcn_global_load_lds((const unsigned*)((const char*)(gbase) + (voff)[_i]), (PG8_LAS unsigned*)(lds + (bufoff) + ldsw + _i * 8192), 16, 0, 0); } while (0)
#define PG8_LDA(dst, b, h) do { _Pragma("unroll") for (int m = 0; m < 4; ++m) _Pragma("unroll") for (int k = 0; k < 2; ++k) dst[m][k] = *(const PG8_LAS bf16x8*)(lds + PG8_SA(b, h) + aoff + m * 2048 + k * 1024); } while (0)
#define PG8_LDB(dst, b, h) do { _Pragma("unroll") for (int n = 0; n < 2; ++n) _Pragma("unroll") for (int k = 0; k < 2; ++k) dst[n][k] = *(const PG8_LAS bf16x8*)(lds + PG8_SB(b, h) + boff + n * 2048 + k * 1024); } while (0)
#define PG8_MMA(ai, bj, At, Bt) do { __builtin_amdgcn_s_setprio(1); _Pragma("unroll") for (int m = 0; m < 4; ++m) _Pragma("unroll") for (int n = 0; n < 2; ++n) _Pragma("unroll") for (int k = 0; k < 2; ++k) \
        acc[ai][bj][m][n] = __builtin_amdgcn_mfma_f32_16x16x32_bf16(Bt[n][k], At[m][k], acc[ai][bj][m][n], 0, 0, 0); __builtin_amdgcn_s_setprio(0); } while (0)
#define PG8_WAIT_V(n) asm volatile("s_waitcnt vmcnt(" #n ")" ::: "memory")
#define PG8_WAIT_L(n) asm volatile("s_waitcnt lgkmcnt(" #n ")" ::: "memory")
#define PG8_BAR __builtin_amdgcn_s_barrier()
#define PG8_SCHED __builtin_amdgcn_sched_barrier(0)
    Unit cur, nxt; int ui = 0;
    if (!S.next(0, cur)) return;
    f32x4 acc[2][2][4][2];
#pragma unroll
    for (int a = 0; a < 2; ++a)
#pragma unroll
        for (int b = 0; b < 2; ++b)
#pragma unroll
            for (int m = 0; m < 4; ++m)
#pragma unroll
                for (int n = 0; n < 2; ++n) acc[a][b][m][n] = (f32x4){0.f, 0.f, 0.f, 0.f};
    bf16x8 At[4][2], B0[2][2], B1[2][2];
    const char* cA = (const char*)g.A + (size_t)cur.pm * tstep; const char* cB = (const char*)g.Bt + (size_t)cur.pn * tstep;
    if constexpr (SP2) {
        PG8_STAGE(PG8_SB(0, 0), cB, voffB); PG8_STAGE(PG8_SB(0, 1), cB + hstepB, voffB); PG8_STAGE(PG8_SA(0, 0), cA, voffA); PG8_STAGE(PG8_SA(0, 1), cA + hstepA, voffA);
        if (wr == 1) PG8_BAR;
        PG8_WAIT_V(2); PG8_BAR;
        PG8_STAGE(PG8_SB(1, 0), cB + kstep, voffB); PG8_STAGE(PG8_SA(1, 0), cA + kstep, voffA); PG8_STAGE(PG8_SB(1, 1), cB + hstepB + kstep, voffB);
        PG8_WAIT_V(6); PG8_BAR;
    } else {
        PG8_STAGE(PG8_SB(0, 0), cB, voffB); PG8_STAGE(PG8_SA(0, 0), cA, voffA); PG8_STAGE(PG8_SB(0, 1), cB + hstepB, voffB); PG8_STAGE(PG8_SA(0, 1), cA + hstepA, voffA);
        if (wr == 1) PG8_BAR;
        PG8_WAIT_V(4); PG8_BAR;
        PG8_STAGE(PG8_SB(1, 0), cB + kstep, voffB); PG8_STAGE(PG8_SA(1, 0), cA + kstep, voffA); PG8_STAGE(PG8_SB(1, 1), cB + hstepB + kstep, voffB);
        PG8_WAIT_V(6); PG8_BAR;
    }
    for (;;) {
        const bool has_next = S.next(ui + 1, nxt);
        const char* nA = has_next ? (const char*)g.A + (size_t)nxt.pm * tstep : cA; const char* nB = has_next ? (const char*)g.Bt + (size_t)nxt.pn * tstep : cB;
        for (int t = 0; t < nt; t += 2) {
            const bool last = (t == nt - 2);
            const char* a1 = cA + (size_t)(t + 1) * kstep;
            const char* a2 = last ? nA : cA + (size_t)(t + 2) * kstep; const char* b2 = last ? nB : cB + (size_t)(t + 2) * kstep;
            const char* a3 = a2 + kstep; const char* b3 = b2 + kstep;
            if constexpr (SP2) {
            PG8_LDB(B0, 0, 0); PG8_LDB(B1, 0, 1); PG8_SCHED; PG8_LDA(At, 0, 0); PG8_STAGE(PG8_SA(1, 1), a1 + hstepA, voffA);
            PG8_WAIT_V(8); PG8_WAIT_L(0); PG8_BAR; PG8_MMA(0, 0, At, B0); PG8_MMA(0, 1, At, B1); PG8_BAR; PG8_SCHED;
            PG8_LDA(At, 0, 1); PG8_STAGE(PG8_SB(0, 0), b2, voffB); PG8_STAGE(PG8_SB(0, 1), b2 + hstepB, voffB); PG8_STAGE(PG8_SA(0, 0), a2, voffA);
            PG8_WAIT_V(8); PG8_WAIT_L(0); PG8_BAR; PG8_MMA(1, 0, At, B0); PG8_MMA(1, 1, At, B1); PG8_BAR; PG8_SCHED;
            PG8_LDB(B0, 1, 0); PG8_LDB(B1, 1, 1); PG8_SCHED; PG8_LDA(At, 1, 0); PG8_STAGE(PG8_SA(0, 1), a2 + hstepA, voffA);
            PG8_WAIT_V(8); PG8_WAIT_L(0); PG8_BAR; PG8_MMA(0, 0, At, B0); PG8_MMA(0, 1, At, B1); PG8_BAR; PG8_SCHED;
            PG8_LDA(At, 1, 1); PG8_STAGE(PG8_SB(1, 0), b3, voffB); PG8_STAGE(PG8_SB(1, 1), b3 + hstepB, voffB); PG8_STAGE(PG8_SA(1, 0), a3, voffA);
            PG8_WAIT_V(8); PG8_WAIT_L(0); PG8_BAR; PG8_MMA(1, 0, At, B0); PG8_MMA(1, 1, At, B1); PG8_BAR; PG8_SCHED;
            } else {
            PG8_LDB(B0, 0, 0); PG8_SCHED; PG8_LDA(At, 0, 0); PG8_STAGE(PG8_SA(1, 1), a1 + hstepA, voffA);
            PG8_WAIT_L(8); PG8_BAR; PG8_WAIT_L(0); PG8_MMA(0, 0, At, B0); PG8_BAR; PG8_SCHED;
            PG8_LDB(B1, 0, 1); PG8_STAGE(PG8_SB(0, 0), b2, voffB);
            PG8_BAR; PG8_WAIT_L(0); PG8_MMA(0, 1, At, B1); PG8_BAR;
            PG8_LDA(At, 0, 1); PG8_STAGE(PG8_SA(0, 0), a2, voffA);
            PG8_BAR; PG8_WAIT_L(0); PG8_MMA(1, 0, At, B0); PG8_BAR; PG8_SCHED;
            PG8_STAGE(PG8_SB(0, 1), b2 + hstepB, voffB);
            PG8_WAIT_V(6); PG8_BAR; PG8_MMA(1, 1, At, B1); PG8_BAR;
            PG8_LDB(B0, 1, 0); PG8_SCHED; PG8_LDA(At, 1, 0); PG8_STAGE(PG8_SA(0, 1), a2 + hstepA, voffA);
            PG8_WAIT_L(8); PG8_BAR; PG8_WAIT_L(0); PG8_MMA(0, 0, At, B0); PG8_BAR; PG8_SCHED;
            PG8_LDB(B1, 1, 1); PG8_STAGE(PG8_SB(1, 0), b3, voffB);
            PG8_BAR; PG8_WAIT_L(0); PG8_MMA(0, 1, At, B1); PG8_BAR;
            PG8_LDA(At, 1, 1); PG8_STAGE(PG8_SA(1, 0), a3, voffA);
            PG8_BAR; PG8_WAIT_L(0); PG8_MMA(1, 0, At, B0); PG8_BAR; PG8_SCHED;
            PG8_STAGE(PG8_SB(1, 1), b3 + hstepB, voffB);
            PG8_WAIT_V(6); PG8_BAR; PG8_MMA(1, 1, At, B1); PG8_BAR;
            }
        }
        if constexpr (ALIGN_EPI) { if (wr == 0) PG8_BAR; }
        E(acc, cur, wr, wc, fr, fq, lds, ui);
        if (!has_next) break;
#pragma unroll
        for (int a = 0; a < 2; ++a)
#pragma unroll
            for (int b = 0; b < 2; ++b)
#pragma unroll
                for (int m = 0; m < 4; ++m)
#pragma unroll
                    for (int n = 0; n < 2; ++n) acc[a][b][m][n] = (f32x4){0.f, 0.f, 0.f, 0.f};
        cur = nxt; cA = nA; cB = nB; ++ui;
        if constexpr (ALIGN_EPI) { if (wr == 1) PG8_BAR; }
    }
    PG8_WAIT_V(0);
    if constexpr (!ALIGN_EPI) { if (wr == 0) PG8_BAR; }
    PG8_BAR;
#undef PG8_SA
#undef PG8_SB
#undef PG8_STAGE
#undef PG8_LDA
#undef PG8_LDB
#undef PG8_MMA
#undef PG8_WAIT_V
#undef PG8_WAIT_L
#undef PG8_BAR
#undef PG8_SCHED
}
}

#define LAS __attribute__((address_space(3)))
typedef unsigned short bf16_t;
typedef float f32x4 __attribute__((ext_vector_type(4)));
typedef unsigned u32x4 __attribute__((ext_vector_type(4)));
typedef unsigned u32x2 __attribute__((ext_vector_type(2)));

constexpr int D = 1024, BATCH = 4, SEQ = 4096, M = BATCH * SEQ;
constexpr int NH = 4, DV = 128, DK = 64, CH = 64, NCH = SEQ / CH;
constexpr int NP = 2048, DFF = 2816, INW = 2056;
constexpr int NUNIT = BATCH * NH * NCH;
constexpr float EPS = 1e-6f;
constexpr int NT = 512, NWAVES = 8;

constexpr size_t MiB = 1u << 20;
constexpr size_t WS_WIN = 0, WS_WOUT = 4 * MiB, WS_WUP = 6 * MiB, WS_WDN = 17 * MiB;
constexpr size_t WS_WL1 = 100 * MiB;
constexpr size_t WS_BC = 122 * MiB + 512 * 1024;
constexpr size_t WS_UU = 123 * MiB;
constexpr size_t WS_FSLOT = 124 * MiB;
constexpr size_t WS_FCNT = 31 * MiB + 16384;
constexpr size_t WS_SMALL = 23 * MiB;
constexpr size_t WS_WG = WS_SMALL;
constexpr size_t WS_G = WS_SMALL + 64 * 1024;
constexpr size_t WS_SS = 80 * MiB;
constexpr size_t WS_BL = WS_G + 512 * 1024 + 320 * 1024;
constexpr size_t WS_ML = WS_BL + 4096;
constexpr size_t WS_MP = WS_ML + 4096;
constexpr size_t WS_NST = WS_SMALL + 1 * MiB;
constexpr size_t WS_WPT = WS_SMALL + 1 * MiB + 256 * 1024;
constexpr size_t WS_QKC = 84 * MiB;
constexpr size_t WS_CPB = 64 * MiB;
constexpr size_t WS_HEAD = WS_SMALL + 2 * MiB;
constexpr size_t WS_TAIL = WS_SMALL + 5 * MiB;
constexpr size_t WS_XN = 32 * MiB;
constexpr size_t WS_XA = 64 * MiB;
constexpr size_t WS_P = 128 * MiB;
constexpr size_t WS_CST = 192 * MiB;
constexpr size_t WS_HCAT = 224 * MiB;
constexpr size_t WS_ACT = 128 * MiB;
constexpr size_t WS_END = 256 * MiB;
constexpr int LDS_BYTES = 163840;
constexpr int RST_OFF = 131072;
constexpr int XCH_OFF = 155648;
constexpr int MISC_OFF = 159744;
constexpr size_t WS_CTL = 31 * MiB;

struct Params { const float* in[15]; float* out; unsigned char* ws; };

__device__ __forceinline__ float bf_lo(unsigned w) { return __uint_as_float(w << 16); }
__device__ __forceinline__ float bf_hi(unsigned w) { return __uint_as_float(w & 0xffff0000u); }
__device__ __forceinline__ unsigned pk_bf16(float lo, float hi) { unsigned r; asm volatile("v_cvt_pk_bf16_f32 %0, %1, %2" : "=v"(r) : "v"(lo), "v"(hi)); return r; }
__device__ __forceinline__ void unpack8(const u32x4 w, float (&x)[8]) { x[0] = bf_lo(w.x); x[1] = bf_hi(w.x); x[2] = bf_lo(w.y); x[3] = bf_hi(w.y); x[4] = bf_lo(w.z); x[5] = bf_hi(w.z); x[6] = bf_lo(w.w); x[7] = bf_hi(w.w); }
__device__ __forceinline__ float shfl_idx(float v, int src) { return __builtin_bit_cast(float, __builtin_amdgcn_ds_bpermute(src << 2, __builtin_bit_cast(int, v))); }
__device__ __forceinline__ float wave_sum(float v, int lane) {
#pragma unroll
    for (int o = 1; o < 64; o <<= 1) v += shfl_idx(v, lane ^ o);
    return v;
}
__device__ __forceinline__ float wave_max(float v, int lane) {
#pragma unroll
    for (int o = 1; o < 64; o <<= 1) v = fmaxf(v, shfl_idx(v, lane ^ o));
    return v;
}
__device__ __forceinline__ float wave_incl_sum(float v, int lane) {
#pragma unroll
    for (int o = 1; o < 64; o <<= 1) { const float t = shfl_idx(v, lane - o); if (lane >= o) v += t; }
    return v;
}
__device__ __forceinline__ float wave_incl_max(float v, int lane) {
#pragma unroll
    for (int o = 1; o < 64; o <<= 1) { const float t = shfl_idx(v, lane - o); if (lane >= o) v = fmaxf(v, t); }
    return v;
}
__device__ __forceinline__ float log_sigmoid(float x) { return fminf(x, 0.f) - log1pf(expf(-fabsf(x))); }
__device__ __forceinline__ float sigmoid_f(float x) { return 1.f / (1.f + expf(-x)); }
__device__ __forceinline__ float silu_f(float x) { return x / (1.f + expf(-x)); }
__device__ __forceinline__ float exp_fast(float x) { return __builtin_amdgcn_exp2f(x * 1.44269504f); }
__device__ __forceinline__ float sigmoid_fast(float x) { return __builtin_amdgcn_rcpf(1.f + __builtin_amdgcn_exp2f(x * -1.44269504f)); }
__device__ __forceinline__ float silu_fast(float x) { return x * sigmoid_fast(x); }
#define LDS_WAIT() asm volatile("s_waitcnt lgkmcnt(0)" ::: "memory")
__device__ __forceinline__ void store16_wt(__amdgpu_buffer_rsrc_t rsrc, unsigned byte_off, u32x4 v) { __builtin_amdgcn_raw_buffer_store_b128(v, rsrc, (int)byte_off, 0, 16); }
__device__ __forceinline__ float ss_row(const float* SS, int row) { const f32x4 v = *(const f32x4*)(SS + (size_t)row * 4); return (v[0] + v[1]) + (v[2] + v[3]); }

struct EpiIn {
    static constexpr bool PERM = true, ROWPERM = false;
    bf16_t* P; const float* SS;
    __device__ __forceinline__ void operator()(pg8::f32x4 (&acc)[2][2][4][2], const pg8::Unit& u, int wr, int wc, int fr, int fq, PG8_LAS unsigned char*, int) const {
        const int row0 = u.pm * 256 + wr * 64 + fr, col0 = u.pn * 256 + wc * 32 + 8 * fq;
        const __amdgpu_buffer_rsrc_t prs = __builtin_amdgcn_make_buffer_rsrc((void*)P, (short)0, (int)((size_t)M * NP * 2), 0x00020000);
#pragma unroll
        for (int ai = 0; ai < 2; ++ai)
#pragma unroll
            for (int m = 0; m < 4; ++m) {
                const int row = row0 + ai * 128 + m * 16;
                const float rs = rsqrtf(ss_row(SS, row) * (1.f / D) + EPS);
                bf16_t* rowp = P + (size_t)row * NP + col0;
#pragma unroll
                for (int bj = 0; bj < 2; ++bj) {
                    const pg8::f32x4 v0 = acc[ai][bj][m][0] * rs, v1 = acc[ai][bj][m][1] * rs;
                    u32x4 w; w.x = pk_bf16(v0[0], v0[1]); w.y = pk_bf16(v0[2], v0[3]); w.z = pk_bf16(v1[0], v1[1]); w.w = pk_bf16(v1[2], v1[3]);
                    store16_wt(prs, (unsigned)(((size_t)row * NP + col0 + bj * 128) * 2), w);
                }
            }
    }
};
struct EpiRes {
    static constexpr bool PERM = true, ROWPERM = false;
    bf16_t* xn; float* ss;
    __device__ __forceinline__ void operator()(pg8::f32x4 (&acc)[2][2][4][2], const pg8::Unit& u, int wr, int wc, int fr, int fq, PG8_LAS unsigned char* lds, int ui) const {
        const int row0 = u.pm * 256 + wr * 64 + fr, col0 = u.pn * 256 + wc * 32 + 8 * fq;
        PG8_LAS float* xs = (PG8_LAS float*)(lds + XCH_OFF);
        const __amdgpu_buffer_rsrc_t xrs = __builtin_amdgcn_make_buffer_rsrc((void*)xn, (short)0, (int)((size_t)M * D * 2), 0x00020000);
#pragma unroll
        for (int ai = 0; ai < 2; ++ai) {
            u32x4 r[4][2];
#pragma unroll
            for (int m = 0; m < 4; ++m)
#pragma unroll
                for (int bj = 0; bj < 2; ++bj) r[m][bj] = *(const u32x4*)(xn + (size_t)(row0 + ai * 128 + m * 16) * D + col0 + bj * 128);
#pragma unroll
            for (int m = 0; m < 4; ++m) {
                const int row = row0 + ai * 128 + m * 16;
                const size_t off = (size_t)row * D + col0;
                float part = 0.f;
#pragma unroll
                for (int bj = 0; bj < 2; ++bj) {
                    const u32x4 rv = r[m][bj];
                    const pg8::f32x4 o0 = acc[ai][bj][m][0] + (pg8::f32x4){bf_lo(rv.x), bf_hi(rv.x), bf_lo(rv.y), bf_hi(rv.y)};
                    const pg8::f32x4 o1 = acc[ai][bj][m][1] + (pg8::f32x4){bf_lo(rv.z), bf_hi(rv.z), bf_lo(rv.w), bf_hi(rv.w)};
                    u32x4 w; w.x = pk_bf16(o0[0], o0[1]); w.y = pk_bf16(o0[2], o0[3]); w.z = pk_bf16(o1[0], o1[1]); w.w = pk_bf16(o1[2], o1[3]);
                    store16_wt(xrs, (unsigned)((off + bj * 128) * 2), w);
                    part += ((o0[0] * o0[0] + o0[1] * o0[1]) + (o0[2] * o0[2] + o0[3] * o0[3])) + ((o1[0] * o1[0] + o1[1] * o1[1]) + (o1[2] * o1[2] + o1[3] * o1[3]));
                }
                { const int ln = fq * 16 + fr; part += shfl_idx(part, ln ^ 16); part += shfl_idx(part, ln ^ 32); }
                if (fq == 0) xs[(ai * 128 + wr * 64 + m * 16 + fr) * 4 + wc] = part;
            }
            asm volatile("" ::: "memory");
        }
        LDS_WAIT(); __builtin_amdgcn_s_barrier(); asm volatile("" ::: "memory");
        if (wr == 0) { const int r = wc * 64 + fq * 16 + fr; const pg8::f32x4 v = *(PG8_LAS pg8::f32x4*)(xs + r * 4);
            ss[(size_t)(u.pm * 256 + r) * 4 + u.pn] = (v[0] + v[1]) + (v[2] + v[3]); }
    }
};
struct EpiFinal {
    static constexpr bool PERM = true, ROWPERM = false;
    const bf16_t* xn; float* out; const float* gf; float* slots; unsigned* cnt;
    __device__ __forceinline__ void operator()(pg8::f32x4 (&acc)[2][2][4][2], const pg8::Unit& u, int wr, int wc, int fr, int fq, PG8_LAS unsigned char* lds, int ui) const {
        const int row0 = u.pm * 256 + wr * 64 + fr, col0 = u.pn * 256 + wc * 32 + 8 * fq;
        PG8_LAS float* xs = (PG8_LAS float*)(lds + XCH_OFF);
#pragma unroll
        for (int ai = 0; ai < 2; ++ai) {
            u32x4 r[4][2];
#pragma unroll
            for (int m = 0; m < 4; ++m)
#pragma unroll
                for (int bj = 0; bj < 2; ++bj) r[m][bj] = *(const u32x4*)(xn + (size_t)(row0 + ai * 128 + m * 16) * D + col0 + bj * 128);
#pragma unroll
            for (int m = 0; m < 4; ++m) {
                float part = 0.f;
#pragma unroll
                for (int bj = 0; bj < 2; ++bj) {
                    const u32x4 rv = r[m][bj];
                    const pg8::f32x4 o0 = acc[ai][bj][m][0] + (pg8::f32x4){bf_lo(rv.x), bf_hi(rv.x), bf_lo(rv.y), bf_hi(rv.y)};
                    const pg8::f32x4 o1 = acc[ai][bj][m][1] + (pg8::f32x4){bf_lo(rv.z), bf_hi(rv.z), bf_lo(rv.w), bf_hi(rv.w)};
                    acc[ai][bj][m][0] = o0; acc[ai][bj][m][1] = o1;
                    part += ((o0[0] * o0[0] + o0[1] * o0[1]) + (o0[2] * o0[2] + o0[3] * o0[3])) + ((o1[0] * o1[0] + o1[1] * o1[1]) + (o1[2] * o1[2] + o1[3] * o1[3]));
                }
                { const int ln = fq * 16 + fr; part += shfl_idx(part, ln ^ 16); part += shfl_idx(part, ln ^ 32); }
                if (fq == 0) xs[(ai * 128 + wr * 64 + m * 16 + fr) * 4 + wc] = part;
            }
            asm volatile("" ::: "memory");
        }
        LDS_WAIT(); __builtin_amdgcn_s_barrier(); asm volatile("" ::: "memory");
        unsigned* pc = cnt + 64 * u.pm;
        if (wr == 0) {
            const int r = wc * 64 + fq * 16 + fr; const pg8::f32x4 v = *(PG8_LAS pg8::f32x4*)(xs + r * 4);
            __hip_atomic_store(slots + (size_t)u.pn * M + u.pm * 256 + r, (v[0] + v[1]) + (v[2] + v[3]), __ATOMIC_RELAXED, __HIP_MEMORY_SCOPE_AGENT);
            asm volatile("s_waitcnt vmcnt(0)" ::: "memory");
            if (fq == 0 && fr == 0) __hip_atomic_fetch_add(pc, 1u, __ATOMIC_RELAXED, __HIP_MEMORY_SCOPE_AGENT);
            if (wc == 0) {
                unsigned spins = 0;
                while ((unsigned)__builtin_amdgcn_readfirstlane((int)__hip_atomic_load(pc, __ATOMIC_RELAXED, __HIP_MEMORY_SCOPE_AGENT)) < 16u) { __builtin_amdgcn_s_sleep(2); if (++spins > (1u << 22)) break; }
                __builtin_amdgcn_fence(__ATOMIC_ACQUIRE, "agent");
                asm volatile("s_waitcnt vmcnt(0)" ::: "memory");
            }
        }
        asm volatile("s_waitcnt vmcnt(0) lgkmcnt(0)" ::: "memory"); __builtin_amdgcn_s_barrier(); asm volatile("" ::: "memory");
#pragma unroll
        for (int ai = 0; ai < 2; ++ai)
#pragma unroll
            for (int m = 0; m < 4; ++m) {
                const int row = row0 + ai * 128 + m * 16;
                float t4[4];
#pragma unroll
                for (int t = 0; t < 4; ++t) t4[t] = __hip_atomic_load(slots + (size_t)t * M + row, __ATOMIC_RELAXED, __HIP_MEMORY_SCOPE_AGENT);
                const float rs = rsqrtf(((t4[0] + t4[1]) + (t4[2] + t4[3])) * (1.f / D) + EPS);
#pragma unroll
                for (int bj = 0; bj < 2; ++bj) {
                    const pg8::f32x4 g0 = *(const pg8::f32x4*)(gf + col0 + bj * 128), g1 = *(const pg8::f32x4*)(gf + col0 + bj * 128 + 4);
                    __builtin_nontemporal_store(acc[ai][bj][m][0] * rs * g0, (pg8::f32x4*)(out + (size_t)row * D + col0 + bj * 128));
                    __builtin_nontemporal_store(acc[ai][bj][m][1] * rs * g1, (pg8::f32x4*)(out + (size_t)row * D + col0 + bj * 128 + 4));
                }
            }
    }
};
struct EpiUp {
    static constexpr bool PERM = true, ROWPERM = true;
    bf16_t* ACT; const float* SS; const float* cw; const float* cb; float* HEAD; float* TAIL;
    __device__ __forceinline__ void operator()(pg8::f32x4 (&acc)[2][2][4][2], const pg8::Unit& u, int wr, int wc, int fr, int fq, PG8_LAS unsigned char* lds, int ui) const {
        asm volatile("" : "+v"(fr), "+v"(fq));
        const int tok0 = u.pm * 256 + (wr * 16 + fr) * 8;
        const int cbase = u.pn * 128 + wc * 32 + 8 * fq;
        const __amdgpu_buffer_rsrc_t ars = __builtin_amdgcn_make_buffer_rsrc((void*)ACT, (short)0, (int)((size_t)M * DFF * 2), 0x00020000);
#pragma unroll
        for (int ai = 0; ai < 2; ++ai) {
            const pg8::f32x4 rs4 = *(PG8_LAS pg8::f32x4*)(lds + RST_OFF + (ui * 256 + (wr * 16 + fr) * 8 + ai * 4) * 4);
#pragma unroll
            for (int m = 0; m < 4; ++m)
#pragma unroll
                for (int bj = 0; bj < 2; ++bj)
#pragma unroll
                    for (int n = 0; n < 2; ++n) acc[ai][bj][m][n] *= rs4[m];
        }
        PG8_LAS float* xch = (PG8_LAS float*)(lds + XCH_OFF) + (wc * 4 + fq) * 64;
        if (fr == 15) {
            if (wr == 0) {
#pragma unroll
                for (int tk = 0; tk < 2; ++tk)
#pragma unroll
                    for (int bj = 0; bj < 2; ++bj)
#pragma unroll
                        for (int n = 0; n < 2; ++n) *(PG8_LAS pg8::f32x4*)(xch + tk * 32 + bj * 8 + n * 4) = acc[1][bj][2 + tk][n];
            } else {
#pragma unroll
                for (int tk = 0; tk < 2; ++tk)
#pragma unroll
                    for (int bj = 0; bj < 2; ++bj)
#pragma unroll
                        for (int n = 0; n < 2; ++n) *(pg8::f32x4*)(TAIL + ((size_t)u.pm * 2 + tk) * (2 * DFF) + bj * DFF + cbase + 4 * n) = acc[1][bj][2 + tk][n];
            }
        }
        if (fr == 0 && wr == 0) {
#pragma unroll
            for (int tk = 0; tk < 2; ++tk)
#pragma unroll
                for (int bj = 0; bj < 2; ++bj)
#pragma unroll
                    for (int n = 0; n < 2; ++n) *(pg8::f32x4*)(HEAD + ((size_t)u.pm * 2 + tk) * (2 * DFF) + bj * DFF + cbase + 4 * n) = acc[0][bj][tk][n];
        }
        LDS_WAIT(); __builtin_amdgcn_s_barrier(); asm volatile("" ::: "memory");
#pragma unroll
        for (int n = 0; n < 2; ++n)
#pragma unroll
            for (int bj = 0; bj < 2; ++bj) {
                const int cc = bj * DFF + cbase + 4 * n;
                const pg8::f32x4 w0 = *(const pg8::f32x4*)(cw + cc), w1 = *(const pg8::f32x4*)(cw + 2 * DFF + cc), w2 = *(const pg8::f32x4*)(cw + 4 * DFF + cc), bb = *(const pg8::f32x4*)(cb + cc);
                pg8::f32x4 p1, p2;
#pragma unroll
                for (int j = 0; j < 4; ++j) {
                    p1[j] = shfl_idx(acc[1][bj][3][n][j], fq * 16 + fr - 1);
                    p2[j] = shfl_idx(acc[1][bj][2][n][j], fq * 16 + fr - 1);
                }
                if (fr == 0) {
                    if (wr == 1) { p2 = *(PG8_LAS pg8::f32x4*)(xch + 0 * 32 + bj * 8 + n * 4); p1 = *(PG8_LAS pg8::f32x4*)(xch + 1 * 32 + bj * 8 + n * 4); }
                    else { p1 = p2 = (pg8::f32x4){0.f, 0.f, 0.f, 0.f}; }
                }
#pragma unroll
                for (int t = 7; t >= 0; --t) {
                    const pg8::f32x4 x0 = acc[t >> 2][bj][t & 3][n];
                    const pg8::f32x4 x1 = (t >= 1) ? acc[(t - 1) >> 2][bj][(t - 1) & 3][n] : p1;
                    const pg8::f32x4 x2 = (t >= 2) ? acc[(t - 2) >> 2][bj][(t - 2) & 3][n] : (t == 1 ? p1 : p2);
                    acc[t >> 2][bj][t & 3][n] = w0 * x2 + w1 * x1 + w2 * x0 + bb;
                }
                asm volatile("" ::: "memory");
            }
#pragma unroll
        for (int t = 0; t < 8; ++t) {
            if (t < 2 && fr == 0 && wr == 0) continue;
            pg8::f32x4 a, b;
#pragma unroll
            for (int j = 0; j < 4; ++j) {
                const float g0 = acc[t >> 2][0][t & 3][0][j], g1 = acc[t >> 2][0][t & 3][1][j];
                a[j] = g0 * __builtin_amdgcn_rcpf(1.f + __builtin_amdgcn_exp2f(-1.44269504f * g0)) * acc[t >> 2][1][t & 3][0][j];
                b[j] = g1 * __builtin_amdgcn_rcpf(1.f + __builtin_amdgcn_exp2f(-1.44269504f * g1)) * acc[t >> 2][1][t & 3][1][j];
            }
            u32x4 w; w.x = pk_bf16(a[0], a[1]); w.y = pk_bf16(a[2], a[3]); w.z = pk_bf16(b[0], b[1]); w.w = pk_bf16(b[2], b[3]);
            store16_wt(ars, (unsigned)(((size_t)(tok0 + t) * DFF + cbase) * 2), w);
        }
    }
};

__device__ __forceinline__ void transpose_item(const float* W, int ldw, int src_col0, int k0, bf16_t* WT, int K, int dst_row0, const float* gain, LAS float* scr, int lane) {
#pragma unroll
    for (int h2 = 0; h2 < 2; ++h2) { float v[16];
#pragma unroll
        for (int i = 0; i < 16; ++i) { const int kk = 2 * (16 * h2 + i) + (lane >> 5); v[i] = __builtin_nontemporal_load(W + (size_t)(k0 + kk) * ldw + src_col0 + (lane & 31));   }
#pragma unroll
        for (int i = 0; i < 16; ++i) { const int kk = 2 * (16 * h2 + i) + (lane >> 5); scr[kk * 33 + (lane & 31)] = gain ? v[i] * gain[k0 + kk] : v[i]; } }
    LDS_WAIT();
    const int c = lane & 7;
#pragma unroll
    for (int j = 0; j < 4; ++j) { const int n = (lane >> 3) + 8 * j; const LAS float* s = scr + (8 * c) * 33 + n;
        u32x4 o; o.x = pk_bf16(s[0 * 33], s[1 * 33]); o.y = pk_bf16(s[2 * 33], s[3 * 33]); o.z = pk_bf16(s[4 * 33], s[5 * 33]); o.w = pk_bf16(s[6 * 33], s[7 * 33]);
        *(u32x4*)(WT + (size_t)(dst_row0 + n) * K + k0 + 8 * c) = o; }
    LDS_WAIT();
}
__device__ __forceinline__ void convert_weights(const Params& p, int l, int mask, int gw, int NGW, LAS float* scr, int lane) {
    const int n_in = (mask & 1) ? 1024 : 0, n_out = (mask & 2) ? 512 : 0, n_up = (mask & 4) ? 2816 : 0, n_dn = (mask & 8) ? 1408 : 0;
    const int total = n_in + n_out + n_up + n_dn;
    for (int it = gw; it < total; it += NGW) {
        int r = it;
        if (r < n_in) { const int kb = r >> 6, nb = r & 63;
            transpose_item(p.in[2] + (size_t)l * D * INW, INW, 32 * nb + (nb >= 48 ? 8 : 0), 64 * kb, (bf16_t*)(p.ws + WS_WIN + (size_t)l * WS_WL1), D, 32 * nb, p.in[1] + l * D, scr, lane); continue; }
        r -= n_in;
        if (r < n_out) { const int kb = r >> 5, nb = r & 31;
            transpose_item(p.in[8] + (size_t)l * D * D, D, 32 * nb, 64 * kb, (bf16_t*)(p.ws + WS_WOUT + (size_t)l * WS_WL1), D, 32 * nb, nullptr, scr, lane); continue; }
        r -= n_out;
        if (r < n_up) { const int kb = r / 176, nb = r % 176, pn = nb >> 3, j = nb & 7; const int src = (j < 4) ? 128 * pn + 32 * j : DFF + 128 * pn + 32 * (j - 4);
            transpose_item(p.in[10] + (size_t)l * D * 2 * DFF, 2 * DFF, src, 64 * kb, (bf16_t*)(p.ws + WS_WUP + (size_t)l * WS_WL1), D, 32 * nb, p.in[9] + l * D, scr, lane); continue; }
        r -= n_up;
        { const int kb = r >> 5, nb = r & 31;
            transpose_item(p.in[13] + (size_t)l * DFF * D, D, 32 * nb, 64 * kb, (bf16_t*)(p.ws + WS_WDN + (size_t)l * WS_WL1), DFF, 32 * nb, nullptr, scr, lane); }
    }
}
__device__ __forceinline__ void gates_rows(const Params& p, int l, const float* SS, int gw, int NGW, int lane) {
    typedef short bf16x8g __attribute__((ext_vector_type(8)));
    const bf16_t* WGb = (const bf16_t*)(p.ws + WS_WG) + l * 16384; const bf16_t* XN = (const bf16_t*)(p.ws + WS_XN); float* G = (float*)(p.ws + WS_G); const float* bgt = p.in[3] + l * 8;
    const int fr = lane & 15, fq = lane >> 4;
    for (int rg = gw; rg < M / 16; rg += NGW) {
        const bf16_t* ap = XN + (size_t)(rg * 16 + fr) * D + 8 * fq; const bf16_t* bp = WGb + fr * D + 8 * fq;
        f32x4 acc = (f32x4){0.f, 0.f, 0.f, 0.f};
#pragma unroll 8
        for (int kt = 0; kt < 32; ++kt) acc = __builtin_amdgcn_mfma_f32_16x16x32_bf16(*(const bf16x8g*)(ap + 32 * kt), *(const bf16x8g*)(bp + 32 * kt), acc, 0, 0, 0);
        if (fr < 8) {
#pragma unroll
            for (int r = 0; r < 4; ++r) { const int tok = rg * 16 + 4 * fq + r; G[(size_t)tok * 8 + fr] = acc[r] * rsqrtf(ss_row(SS, tok) * (1.f / D) + EPS) + bgt[fr]; }
        }
    }
}

typedef short bf16x8v __attribute__((ext_vector_type(8)));
constexpr int PK = 72, PK2 = 136;
__device__ __forceinline__ bf16x8v ldfrag(const LAS bf16_t* base, int pitch, int row, int k0) { return *(const LAS bf16x8v*)(base + row * pitch + k0); }
__device__ __forceinline__ bf16x8v ldfrag_sw(const LAS bf16_t* base, int pitch, int row, int k0) { return *(const LAS bf16x8v*)(base + row * pitch + (k0 ^ (((row >> 3) & 7) << 3))); }
__device__ __forceinline__ bf16_t f2bf1(float x) { return (bf16_t)(pk_bf16(x, 0.f) & 0xffffu); }

__device__ __forceinline__ void conv8(const bf16_t* P, const float* wconv, int b, int c, int s, int col, float (&a)[8]) {
#pragma unroll
    for (int i = 0; i < 8; ++i) a[i] = 0.f;
#pragma unroll
    for (int j = 0; j < 4; ++j) {
        const int pos = c * CH + s - 3 + j;
        if (pos >= 0) {
            const u32x4 w = *(const u32x4*)(P + (size_t)(b * SEQ + pos) * NP + col);
            float x[8]; unpack8(w, x);
            const f32x4 c0 = *(const f32x4*)(wconv + j * 512 + col), c1 = *(const f32x4*)(wconv + j * 512 + col + 4);
            a[0] += c0[0] * x[0]; a[1] += c0[1] * x[1]; a[2] += c0[2] * x[2]; a[3] += c0[3] * x[3];
            a[4] += c1[0] * x[4]; a[5] += c1[1] * x[5]; a[6] += c1[2] * x[6]; a[7] += c1[3] * x[7];
        }
    }
#pragma unroll
    for (int i = 0; i < 8; ++i) a[i] = silu_fast(a[i]);
}
template <int NTU = 256>
__device__ __forceinline__ void load_vT(const bf16_t* P, int tok0, int h, LAS bf16_t* dst, int tid) {
    constexpr int NR = 1024 / NTU;
    u32x4 w[NR];
#pragma unroll
    for (int r = 0; r < NR; ++r) { const int id = tid + NTU * r, s = id >> 4, e8 = id & 15; w[r] = *(const u32x4*)(P + (size_t)(tok0 + s) * NP + 512 + h * DV + 8 * e8); }
#pragma unroll
    for (int r = 0; r < NR; ++r) { const int id = tid + NTU * r, s = id >> 4, e8 = id & 15;
        LAS bf16_t* d = dst + (8 * e8) * PK + (s ^ ((e8 & 7) << 3));
        d[0 * PK] = (bf16_t)(w[r].x & 0xffffu); d[1 * PK] = (bf16_t)(w[r].x >> 16); d[2 * PK] = (bf16_t)(w[r].y & 0xffffu); d[3 * PK] = (bf16_t)(w[r].y >> 16);
        d[4 * PK] = (bf16_t)(w[r].z & 0xffffu); d[5 * PK] = (bf16_t)(w[r].z >> 16); d[6 * PK] = (bf16_t)(w[r].w & 0xffffu); d[7 * PK] = (bf16_t)(w[r].w >> 16); }
}

constexpr int B1_LDS = 28672;
__device__ __forceinline__ void b1_chunk_unit(const Params& p, int l, int u, bool valid, LAS unsigned char* lds, int tid) {
    LAS bf16_t* kT = (LAS bf16_t*)lds; LAS bf16_t* vT = (LAS bf16_t*)(lds + 9216); LAS float* wl = (LAS float*)(lds + 27648);
    const bf16_t* P = (const bf16_t*)(p.ws + WS_P); const float* G = (const float*)(p.ws + WS_G);
    const int bh = u >> 6, c = u & 63, b = bh >> 2, h = bh & 3, tok0 = b * SEQ + c * CH, lane = tid & 63, w = tid >> 6, fr = lane & 15, fq = lane >> 4;
    if (tid < 64) {
        const float ig = G[(size_t)(tok0 + lane) * 8 + h], fg = G[(size_t)(tok0 + lane) * 8 + 4 + h];
        const float bc = wave_incl_sum(log_sigmoid(fg), lane);
        const float blast = shfl_idx(bc, 63);
        const float a = blast - bc + ig;
        const float mloc = wave_max(a, lane);
        wl[lane] = expf(a - mloc);
        if (valid) { ((float*)(p.ws + WS_BC))[(size_t)u * 64 + lane] = bc; ((float*)(p.ws + WS_UU))[(size_t)u * 64 + lane] = ig - bc; }
        if (lane == 0 && valid) { ((float*)(p.ws + WS_BL))[u] = blast; ((float*)(p.ws + WS_ML))[u] = mloc; }
    }
    bf16_t* QKC = (bf16_t*)(p.ws + WS_QKC);
#pragma unroll
    for (int rr = 0; rr < 4; ++rr) {
        const int id = tid + 128 * rr, s = id >> 3, dg = id & 7; float a[8];
        conv8(P, p.in[4] + l * 4 * 512, b, c, s, h * DK + 8 * dg, a);
        u32x4 o; o.x = pk_bf16(a[0], a[1]); o.y = pk_bf16(a[2], a[3]); o.z = pk_bf16(a[4], a[5]); o.w = pk_bf16(a[6], a[7]);
        if (valid) *(u32x4*)(QKC + (size_t)(tok0 + s) * 512 + h * DK + 8 * dg) = o;
    }
    __syncthreads();
#pragma unroll
    for (int rr = 0; rr < 4; ++rr) {
        const int id = tid + 128 * rr, s = id >> 3, dg = id & 7; float a[8];
        conv8(P, p.in[4] + l * 4 * 512, b, c, s, 256 + h * DK + 8 * dg, a);
#pragma unroll
        for (int i = 0; i < 8; ++i) a[i] *= 0.125f;
        u32x4 o; o.x = pk_bf16(a[0], a[1]); o.y = pk_bf16(a[2], a[3]); o.z = pk_bf16(a[4], a[5]); o.w = pk_bf16(a[6], a[7]);
        if (valid) *(u32x4*)(QKC + (size_t)(tok0 + s) * 512 + 256 + h * DK + 8 * dg) = o;
        const float ws_ = wl[s];
#pragma unroll
        for (int i = 0; i < 8; ++i) kT[(8 * dg + i) * PK + (s ^ (dg << 3))] = f2bf1(a[i] * ws_);
    }
    load_vT<128>(P, tok0, h, vT, tid);
    __syncthreads();
    bf16_t* CST = (bf16_t*)(p.ws + WS_CST) + (size_t)u * 8192;
#pragma unroll
    for (int e2 = 0; e2 < 4; ++e2) {
        const int et = 4 * w + e2;
        f32x4 acc[4];
#pragma unroll
        for (int i = 0; i < 4; ++i) acc[i] = (f32x4){0.f, 0.f, 0.f, 0.f};
#pragma unroll
        for (int kt = 0; kt < 2; ++kt) {
            const bf16x8v bf = ldfrag_sw(vT, PK, 16 * et + fr, 32 * kt + 8 * fq);
#pragma unroll
            for (int mt = 0; mt < 4; ++mt) acc[mt] = __builtin_amdgcn_mfma_f32_16x16x32_bf16(ldfrag_sw(kT, PK, 16 * mt + fr, 32 * kt + 8 * fq), bf, acc[mt], 0, 0, 0);
        }
        if (valid) {
#pragma unroll
            for (int mt = 0; mt < 4; ++mt) { u32x2 o; o.x = pk_bf16(acc[mt][0], acc[mt][1]); o.y = pk_bf16(acc[mt][2], acc[mt][3]); *(u32x2*)(CST + (16 * et + fr) * 64 + 16 * mt + 4 * fq) = o; }
        }
    }
    if (tid < 64) { float s = 0.f;
#pragma unroll
        for (int i = 0; i < 8; ++i) { const u32x4 q = *(const LAS u32x4*)(kT + tid * PK + 8 * i); float x[8]; unpack8(q, x); s += ((x[0] + x[1]) + (x[2] + x[3])) + ((x[4] + x[5]) + (x[6] + x[7])); }
        if (valid) ((float*)(p.ws + WS_NST))[(size_t)u * 64 + tid] = s; }
    __syncthreads();
}
template <int W>
__device__ __forceinline__ void pool_dm(const bf16_t* P, int tok0, int pos0, int g, LAS bf16_t* dm, int tid) {
    const int tg = tid >> 4, c8 = tid & 15, t0 = 8 * tg;
    const bf16_t* src = P + (size_t)(tok0 + t0) * NP + 1536 + g * 128 + 8 * c8;
    u32x4 raw[W + 7];
#pragma unroll
    for (int i = 0; i < W + 7; ++i) { const int rel = i - (W - 1); raw[i] = (pos0 + t0 + rel >= 0) ? *(const u32x4*)(src + (long)rel * NP) : (u32x4){0u, 0u, 0u, 0u}; }
    float sum[8];
#pragma unroll
    for (int k = 0; k < 8; ++k) sum[k] = 0.f;
#pragma unroll
    for (int i = 0; i < W - 1; ++i) { float x[8]; unpack8(raw[i], x);
#pragma unroll
        for (int k = 0; k < 8; ++k) sum[k] += x[k]; }
#pragma unroll
    for (int tt = 0; tt < 8; ++tt) {
        float cur[8]; unpack8(raw[tt + W - 1], cur);
#pragma unroll
        for (int k = 0; k < 8; ++k) sum[k] += cur[k];
        const int cnt = min(pos0 + t0 + tt + 1, W);
        const float inv = 1.f / (float)cnt;
        float o[8];
#pragma unroll
        for (int k = 0; k < 8; ++k) o[k] = sum[k] * inv - cur[k];
        u32x4 ov; ov.x = pk_bf16(o[0], o[1]); ov.y = pk_bf16(o[2], o[3]); ov.z = pk_bf16(o[4], o[5]); ov.w = pk_bf16(o[6], o[7]);
        *(LAS u32x4*)(dm + (t0 + tt) * PK2 + 8 * c8) = ov;
        float old[8]; unpack8(raw[tt], old);
#pragma unroll
        for (int k = 0; k < 8; ++k) sum[k] -= old[k];
    }
}
__device__ __forceinline__ void pool_unit(const Params& p, int l, int pu, LAS unsigned char* lds, int tid) {
    LAS bf16_t* wT = (LAS bf16_t*)lds; LAS bf16_t* dm = (LAS bf16_t*)(lds + 34816);
    const bf16_t* P = (const bf16_t*)(p.ws + WS_P); bf16_t* HC = (bf16_t*)(p.ws + WS_HCAT);
    const int tb = pu >> 2, g = pu & 3, tok0 = tb * 256, pos0 = tok0 & (SEQ - 1), lane = tid & 63, w = tid >> 6, fr = lane & 15, fq = lane >> 4;
    const bf16_t* wsrc = (const bf16_t*)(p.ws + WS_WPT) + ((size_t)l * 4 + g) * 128 * 128;
#pragma unroll
    for (int r = 0; r < 4; ++r) { const int id = tid + 512 * r, dc = id >> 4, c8 = id & 15; *(LAS u32x4*)(wT + dc * PK2 + 8 * c8) = *(const u32x4*)(wsrc + dc * 128 + 8 * c8); }
    if (g == 0) pool_dm<2>(P, tok0, pos0, g, dm, tid); else if (g == 1) pool_dm<4>(P, tok0, pos0, g, dm, tid); else if (g == 2) pool_dm<8>(P, tok0, pos0, g, dm, tid); else pool_dm<16>(P, tok0, pos0, g, dm, tid);
    __syncthreads();
    bf16x8v af[4];
#pragma unroll
    for (int kt = 0; kt < 4; ++kt) af[kt] = ldfrag(wT, PK2, 16 * w + fr, 32 * kt + 8 * fq);
    const f32x4 ps = *(const f32x4*)(p.in[7] + l * 512 + g * 128 + 16 * w + 4 * fq);
#pragma unroll 4
    for (int nt = 0; nt < 16; ++nt) {
        f32x4 acc = (f32x4){0.f, 0.f, 0.f, 0.f};
#pragma unroll
        for (int kt = 0; kt < 4; ++kt) acc = __builtin_amdgcn_mfma_f32_16x16x32_bf16(af[kt], ldfrag(dm, PK2, 16 * nt + fr, 32 * kt + 8 * fq), acc, 0, 0, 0);
        const f32x4 y = acc * ps; u32x2 o; o.x = pk_bf16(y[0], y[1]); o.y = pk_bf16(y[2], y[3]);
        *(u32x2*)(HC + (size_t)(tok0 + 16 * nt + fr) * D + 512 + g * 128 + 16 * w + 4 * fq) = o;
    }
    __syncthreads();
}
__device__ __forceinline__ void b2_scan_pool(const Params& p, int l, LAS unsigned char* lds, int bx, int G_, int tid) {
    const int grp = tid >> 8, tl = tid & 255, lane = tid & 63, w = tl >> 6, fr = lane & 15, fq = lane >> 4;
    LAS bf16_t* wT = (LAS bf16_t*)lds; LAS bf16_t* dm = (LAS bf16_t*)(lds + 34816);
    LAS float* s_sp = (LAS float*)(lds + 104448); LAS float* s_sl = s_sp + 64;
    const float* BL = (const float*)(p.ws + WS_BL); const float* ML = (const float*)(p.ws + WS_ML); float* MP = (float*)(p.ws + WS_MP);
    const bf16_t* P = (const bf16_t*)(p.ws + WS_P); bf16_t* HC = (bf16_t*)(p.ws + WS_HCAT);
    for (int it = bx; it < 256; it += G_) {
        unsigned cl[64];
        if (grp == 0) {
            int it0 = it; asm volatile("" : "+s"(it0)); const int bh = it0 >> 4, sub = it0 & 15;
            { const unsigned* q = (const unsigned*)((const bf16_t*)(p.ws + WS_CST) + (size_t)bh * 64 * 8192 + sub * 512 + 2 * tl);
              int stride0 = 4096; asm volatile("" : "+v"(stride0));
#pragma unroll
              for (int c = 0; c < 64; ++c) { cl[c] = __builtin_nontemporal_load(q); q += stride0; } }
            if (tl < 64) {
                const float gg = BL[bh * 64 + lane], ml = ML[bh * 64 + lane];
                float m = 0.f, mp = 0.f, mn_own = 0.f;
                for (int c = 0; c < 64; ++c) {
                    const float gc = __builtin_bit_cast(float, __builtin_amdgcn_readlane(__builtin_bit_cast(int, gg), c)), mlc = __builtin_bit_cast(float, __builtin_amdgcn_readlane(__builtin_bit_cast(int, ml), c));
                    const float mn = fmaxf(gc + m, mlc);
                    if (lane == c) { mp = m; mn_own = mn; }
                    m = mn;
                }
                s_sp[lane] = expf(gg + mp - mn_own); s_sl[lane] = expf(ml - mn_own);
                if (sub == 0) MP[bh * 64 + lane] = mp;
            }
        } else {
            int it1 = it; asm volatile("" : "+s"(it1)); const int tb = it1 >> 2, g = it1 & 3, tok0 = tb * 256, pos0 = tok0 & (SEQ - 1);
            const bf16_t* wsrc = (const bf16_t*)(p.ws + WS_WPT) + ((size_t)l * 4 + g) * 128 * 128;
#pragma unroll
            for (int r = 0; r < 8; ++r) { const int id = tl + 256 * r, dc = id >> 4, c8 = id & 15; *(LAS u32x4*)(wT + dc * PK2 + 8 * c8) = *(const u32x4*)(wsrc + dc * 128 + 8 * c8); }
#pragma unroll 1
            for (int r = 0; r < 2; ++r) { const int id = tl + 256 * r;
                if (g == 0) pool_dm<2>(P, tok0, pos0, g, dm, id); else if (g == 1) pool_dm<4>(P, tok0, pos0, g, dm, id); else if (g == 2) pool_dm<8>(P, tok0, pos0, g, dm, id); else pool_dm<16>(P, tok0, pos0, g, dm, id); }
        }
        __syncthreads();
        if (grp == 0) {
            int it0 = it; asm volatile("" : "+s"(it0)); const int bh = it0 >> 4, sub = it0 & 15;
            const LAS float* vsp = s_sp; const LAS float* vsl = s_sl; asm volatile("" : "+v"(vsp), "+v"(vsl));
            {
                const size_t off = (size_t)bh * 64 * 8192 + sub * 512 + 2 * tl;
                const unsigned* base = (const unsigned*)((const bf16_t*)(p.ws + WS_CST) + off); unsigned* ob = (unsigned*)((bf16_t*)(p.ws + WS_CPB) + off);
                int stride = 4096; asm volatile("" : "+v"(stride));
                float c0 = 0.f, c1 = 0.f;
                { unsigned* q = ob;
#pragma unroll
                  for (int c = 0; c < 64; ++c) { *q = pk_bf16(c0, c1); q += stride; const float sp = vsp[c], sl = vsl[c]; c0 = sp * c0 + sl * bf_lo(cl[c]); c1 = sp * c1 + sl * bf_hi(cl[c]); } }
            }
            if (sub == 0 && tl < 64) {
                float* base = (float*)(p.ws + WS_NST) + (size_t)bh * 64 * 64 + tl;
                float cl[64];
#pragma unroll
                for (int c = 0; c < 64; ++c) cl[c] = base[c * 64];
                float cs = 0.f;
#pragma unroll
                for (int c = 0; c < 64; ++c) { base[c * 64] = cs; cs = vsp[c] * cs + vsl[c] * cl[c]; }
            }
        } else {
            int it1 = it; asm volatile("" : "+s"(it1)); const int tb = it1 >> 2, g = it1 & 3, tok0 = tb * 256;
            bf16x8v af[2][4];
#pragma unroll
            for (int d2 = 0; d2 < 2; ++d2)
#pragma unroll
                for (int kt = 0; kt < 4; ++kt) af[d2][kt] = ldfrag(wT, PK2, 32 * w + 16 * d2 + fr, 32 * kt + 8 * fq);
            f32x4 ps[2];
#pragma unroll
            for (int d2 = 0; d2 < 2; ++d2) ps[d2] = *(const f32x4*)(p.in[7] + l * 512 + g * 128 + 32 * w + 16 * d2 + 4 * fq);
#pragma unroll 2
            for (int nt = 0; nt < 16; ++nt) {
                bf16x8v bd[4];
#pragma unroll
                for (int kt = 0; kt < 4; ++kt) bd[kt] = ldfrag(dm, PK2, 16 * nt + fr, 32 * kt + 8 * fq);
#pragma unroll
                for (int d2 = 0; d2 < 2; ++d2) {
                    f32x4 acc = (f32x4){0.f, 0.f, 0.f, 0.f};
#pragma unroll
                    for (int kt = 0; kt < 4; ++kt) acc = __builtin_amdgcn_mfma_f32_16x16x32_bf16(af[d2][kt], bd[kt], acc, 0, 0, 0);
                    const f32x4 y = acc * ps[d2]; u32x2 o; o.x = pk_bf16(y[0], y[1]); o.y = pk_bf16(y[2], y[3]);
                    *(u32x2*)(HC + (size_t)(tok0 + 16 * nt + fr) * D + 512 + g * 128 + 32 * w + 16 * d2 + 4 * fq) = o;
                }
            }
        }
        __syncthreads();
    }
}
constexpr int B3_LDS = 68608;
__device__ __forceinline__ void b3_chunk_unit(const Params& p, int l, int u, bool valid, LAS unsigned char* lds, int tid) {
    LAS bf16_t* qs = (LAS bf16_t*)lds; LAS bf16_t* ks = (LAS bf16_t*)(lds + 9216); LAS bf16_t* vT = (LAS bf16_t*)(lds + 18432); LAS bf16_t* cpT = (LAS bf16_t*)(lds + 36864);
    LAS bf16_t* Sb = (LAS bf16_t*)(lds + 55296); LAS float* sca = (LAS float*)(lds + 64512); LAS float* part = (LAS float*)(lds + 66048);
    LAS float* s_u = sca, * s_bm = sca + 64, * s_m = sca + 128, * s_sc = sca + 192, * s_np = sca + 256, * s_den = sca + 320;
    const bf16_t* P = (const bf16_t*)(p.ws + WS_P); const float* G = (const float*)(p.ws + WS_G); bf16_t* HC = (bf16_t*)(p.ws + WS_HCAT);
    const int bh = u >> 6, c = u & 63, b = bh >> 2, h = bh & 3, tok0 = b * SEQ + c * CH, lane = tid & 63, w = tid >> 6, fr = lane & 15, fq = lane >> 4;
    u32x2 ow[2][4]; f32x4 gh[2];
#pragma unroll
    for (int e2 = 0; e2 < 2; ++e2) { gh[e2] = *(const f32x4*)(p.in[5] + l * 512 + h * DV + 32 * w + 16 * e2 + 4 * fq);
#pragma unroll
        for (int nt = 0; nt < 4; ++nt) ow[e2][nt] = __builtin_nontemporal_load((const u32x2*)(P + (size_t)(tok0 + 16 * nt + fr) * NP + 1024 + h * DV + 32 * w + 16 * e2 + 4 * fq)); }
    if (tid < 64) {
        const float bc = ((const float*)(p.ws + WS_BC))[(size_t)u * 64 + lane], uu = ((const float*)(p.ws + WS_UU))[(size_t)u * 64 + lane];
        const float pm = wave_incl_max(uu, lane);
        const float mprev = ((const float*)(p.ws + WS_MP))[u];
        const float minter = bc + mprev;
        const float mm = fmaxf(minter, bc + pm);
        s_u[lane] = uu; s_bm[lane] = bc - mm; s_m[lane] = mm; s_sc[lane] = expf(minter - mm);
        s_np[lane] = ((const float*)(p.ws + WS_NST))[(size_t)u * 64 + lane];
    }
    { const bf16_t* CPB = (const bf16_t*)(p.ws + WS_CPB) + (size_t)u * 8192;
      u32x4 t[4];
#pragma unroll
      for (int r = 0; r < 4; ++r) { const int id = tid + 256 * r, e = id >> 3, d8 = id & 7; t[r] = __builtin_nontemporal_load((const u32x4*)(CPB + e * 64 + 8 * d8)); }
#pragma unroll
      for (int r = 0; r < 4; ++r) { const int id = tid + 256 * r, e = id >> 3, d8 = id & 7; *(LAS u32x4*)(cpT + e * PK + 8 * d8) = t[r]; } }
    load_vT(P, tok0, h, vT, tid);
    { const bf16_t* QKC = (const bf16_t*)(p.ws + WS_QKC); u32x4 tq[2], tk[2];
#pragma unroll
      for (int rr = 0; rr < 2; ++rr) { const int id = tid + 256 * rr, s = id >> 3, dg = id & 7;
          tq[rr] = __builtin_nontemporal_load((const u32x4*)(QKC + (size_t)(tok0 + s) * 512 + h * DK + 8 * dg)); tk[rr] = __builtin_nontemporal_load((const u32x4*)(QKC + (size_t)(tok0 + s) * 512 + 256 + h * DK + 8 * dg)); }
#pragma unroll
      for (int rr = 0; rr < 2; ++rr) { const int id = tid + 256 * rr, s = id >> 3, dg = id & 7;
          *(LAS u32x4*)(qs + s * PK + 8 * dg) = tq[rr]; *(LAS u32x4*)(ks + s * PK + 8 * dg) = tk[rr]; } }
    __syncthreads();
    {
        const int mt = w;
#pragma unroll
        for (int nt = 0; nt < 4; ++nt) {
            f32x4 acc = (f32x4){0.f, 0.f, 0.f, 0.f};
            if (mt <= nt) {
#pragma unroll
                for (int kt = 0; kt < 2; ++kt) acc = __builtin_amdgcn_mfma_f32_16x16x32_bf16(ldfrag(ks, PK, 16 * mt + fr, 32 * kt + 8 * fq), ldfrag(qs, PK, 16 * nt + fr, 32 * kt + 8 * fq), acc, 0, 0, 0);
            }
            const int j = 16 * nt + fr; const float bm = s_bm[j]; float o[4];
#pragma unroll
            for (int r = 0; r < 4; ++r) { const int s = 16 * mt + 4 * fq + r; o[r] = (s <= j) ? acc[r] * exp_fast(bm + s_u[s]) : 0.f; }
            u32x2 ov; ov.x = pk_bf16(o[0], o[1]); ov.y = pk_bf16(o[2], o[3]);
            *(LAS u32x2*)(Sb + j * PK + 16 * mt + 4 * fq) = ov;
        }
    }
    __syncthreads();
    if (tid < 64) {
        float s1 = 0.f, s2 = 0.f;
#pragma unroll
        for (int i = 0; i < 8; ++i) { const u32x4 a = *(const LAS u32x4*)(Sb + tid * PK + 8 * i), qv = *(const LAS u32x4*)(qs + tid * PK + 8 * i); float x[8], y[8]; unpack8(a, x); unpack8(qv, y);
#pragma unroll
            for (int k = 0; k < 8; ++k) { s1 += x[k]; s2 += y[k] * s_np[8 * i + k]; } }
        s_den[tid] = s1 + s_sc[tid] * s2;
    }
    f32x4 a1[2][4], a2[2][4];
#pragma unroll
    for (int e2 = 0; e2 < 2; ++e2)
#pragma unroll
        for (int nt = 0; nt < 4; ++nt) { a1[e2][nt] = (f32x4){0.f, 0.f, 0.f, 0.f}; a2[e2][nt] = (f32x4){0.f, 0.f, 0.f, 0.f}; }
#pragma unroll
    for (int kt = 0; kt < 2; ++kt) {
        bf16x8v bs[4], bq[4];
#pragma unroll
        for (int nt = 0; nt < 4; ++nt) { bs[nt] = ldfrag(Sb, PK, 16 * nt + fr, 32 * kt + 8 * fq); bq[nt] = ldfrag(qs, PK, 16 * nt + fr, 32 * kt + 8 * fq); }
#pragma unroll
        for (int e2 = 0; e2 < 2; ++e2) {
            const bf16x8v av = ldfrag_sw(vT, PK, 32 * w + 16 * e2 + fr, 32 * kt + 8 * fq), ac = ldfrag(cpT, PK, 32 * w + 16 * e2 + fr, 32 * kt + 8 * fq);
#pragma unroll
            for (int nt = 0; nt < 4; ++nt) {
                a1[e2][nt] = __builtin_amdgcn_mfma_f32_16x16x32_bf16(av, bs[nt], a1[e2][nt], 0, 0, 0);
                a2[e2][nt] = __builtin_amdgcn_mfma_f32_16x16x32_bf16(ac, bq[nt], a2[e2][nt], 0, 0, 0);
            }
        }
    }
    __syncthreads();
#pragma unroll
    for (int nt = 0; nt < 4; ++nt) {
        const int j = 16 * nt + fr; const float sc = s_sc[j];
        const float dn = __builtin_amdgcn_rcpf(fmaxf(fabsf(s_den[j]), exp_fast(-s_m[j])));
        float ssq = 0.f;
#pragma unroll
        for (int e2 = 0; e2 < 2; ++e2) { a1[e2][nt] = (a1[e2][nt] + sc * a2[e2][nt]) * dn;
            ssq += (a1[e2][nt][0] * a1[e2][nt][0] + a1[e2][nt][1] * a1[e2][nt][1]) + (a1[e2][nt][2] * a1[e2][nt][2] + a1[e2][nt][3] * a1[e2][nt][3]); }
        ssq += shfl_idx(ssq, lane ^ 16); ssq += shfl_idx(ssq, lane ^ 32);
        if (fq == 0) part[w * 64 + j] = ssq;
    }
    __syncthreads();
#pragma unroll
    for (int nt = 0; nt < 4; ++nt) {
        const int j = 16 * nt + fr;
        const float tot = (part[j] + part[64 + j]) + (part[128 + j] + part[192 + j]);
        const float rn = rsqrtf(tot * (1.f / DV) + EPS);
#pragma unroll
        for (int e2 = 0; e2 < 2; ++e2) {
            const f32x4 hv = a1[e2][nt]; const u32x2 o = ow[e2][nt]; const f32x4 g4 = gh[e2];
            const f32x4 y = (f32x4){hv[0] * rn * g4[0] * sigmoid_fast(bf_lo(o.x)), hv[1] * rn * g4[1] * sigmoid_fast(bf_hi(o.x)), hv[2] * rn * g4[2] * sigmoid_fast(bf_lo(o.y)), hv[3] * rn * g4[3] * sigmoid_fast(bf_hi(o.y))};
            u32x2 o2; o2.x = pk_bf16(y[0], y[1]); o2.y = pk_bf16(y[2], y[3]);
            if (valid) *(u32x2*)(HC + (size_t)(tok0 + j) * D + h * DV + 32 * w + 16 * e2 + 4 * fq) = o2;
        }
    }
    __syncthreads();
}
__device__ __forceinline__ void ffn_fixup_tile(const Params& p, int l, int pm, int tid) {
    const float* HEAD = (const float*)(p.ws + WS_HEAD); const float* TAIL = (const float*)(p.ws + WS_TAIL); bf16_t* ACT = (bf16_t*)(p.ws + WS_ACT);
    const float* cw = p.in[11] + (size_t)l * 3 * 2 * DFF; const float* cb = p.in[12] + (size_t)l * 2 * DFF;
    const bool first = (pm & 15) == 0;
    for (int id = tid; id < 2 * (DFF / 4); id += NT) {
        const int t = id / (DFF / 4), c = 4 * (id % (DFF / 4));
        f32x4 o[2];
#pragma unroll
        for (int gv = 0; gv < 2; ++gv) {
            const int cc = gv * DFF + c; const f32x4 z = (f32x4){0.f, 0.f, 0.f, 0.f};
            const f32x4 t0 = first ? z : *(const f32x4*)(TAIL + ((size_t)(pm - 1) * 2 + 0) * (2 * DFF) + cc), t1 = first ? z : *(const f32x4*)(TAIL + ((size_t)(pm - 1) * 2 + 1) * (2 * DFF) + cc);
            const f32x4 h0 = *(const f32x4*)(HEAD + ((size_t)pm * 2 + 0) * (2 * DFF) + cc), h1 = *(const f32x4*)(HEAD + ((size_t)pm * 2 + 1) * (2 * DFF) + cc);
            const f32x4 x2 = t ? t1 : t0, x1 = t ? h0 : t1, x0 = t ? h1 : h0;
            o[gv] = *(const f32x4*)(cw + cc) * x2 + *(const f32x4*)(cw + 2 * DFF + cc) * x1 + *(const f32x4*)(cw + 4 * DFF + cc) * x0 + *(const f32x4*)(cb + cc);
        }
        u32x2 w; w.x = pk_bf16(silu_fast(o[0][0]) * o[1][0], silu_fast(o[0][1]) * o[1][1]); w.y = pk_bf16(silu_fast(o[0][2]) * o[1][2], silu_fast(o[0][3]) * o[1][3]);
        *(u32x2*)(ACT + (size_t)(pm * 256 + t) * DFF + c) = w;
    }
}
__device__ __forceinline__ void ffn_fixup(const Params& p, int l, int gt, int GT) {
    const float* HEAD = (const float*)(p.ws + WS_HEAD); const float* TAIL = (const float*)(p.ws + WS_TAIL); bf16_t* ACT = (bf16_t*)(p.ws + WS_ACT);
    const float* cw = p.in[11] + (size_t)l * 3 * 2 * DFF; const float* cb = p.in[12] + (size_t)l * 2 * DFF;
    for (int i = gt; i < 64 * 2 * DFF; i += GT) {
        const int pm = i / (2 * DFF), r = i % (2 * DFF), t = r / DFF, c = r % DFF;
        float o[2];
#pragma unroll
        for (int gv = 0; gv < 2; ++gv) {
            const int cc = gv * DFF + c;
            const bool first = (pm & 15) == 0;
            const float t0 = first ? 0.f : TAIL[((size_t)(pm - 1) * 2 + 0) * (2 * DFF) + cc], t1 = first ? 0.f : TAIL[((size_t)(pm - 1) * 2 + 1) * (2 * DFF) + cc];
            const float h0 = HEAD[((size_t)pm * 2 + 0) * (2 * DFF) + cc], h1 = HEAD[((size_t)pm * 2 + 1) * (2 * DFF) + cc];
            const float x2 = t ? t1 : t0, x1 = t ? h0 : t1, x0 = t ? h1 : h0;
            o[gv] = cw[cc] * x2 + cw[2 * DFF + cc] * x1 + cw[4 * DFF + cc] * x0 + cb[cc];
        }
        const float a = silu_f(o[0]) * o[1];
        ACT[(size_t)(pm * 256 + t) * DFF + c] = (bf16_t)(pk_bf16(a, 0.f) & 0xffffu);
    }
}

#define XB_TMO      128
#define XB_XCNT(j)  (256  + 64 * (j))
#define XB_XSUB(j)  (1280 + 64 * (j))
#define XB_XGEN(j)  (2304 + 64 * (j))
#define XB_TOP      3328
#define XB_TOPGEN   3392
#define XCD_BAR_WORDS 3456
#define XB_SPIN_CAP (1u << 18)

__device__ __forceinline__ unsigned xb_ld(unsigned* p)              { return __hip_atomic_load(p, __ATOMIC_RELAXED, __HIP_MEMORY_SCOPE_AGENT); }
__device__ __forceinline__ unsigned xb_add(unsigned* p, unsigned v) { return __hip_atomic_fetch_add(p, v, __ATOMIC_RELAXED, __HIP_MEMORY_SCOPE_AGENT); }
__device__ __forceinline__ unsigned xb_xcc_id() { return (unsigned)__builtin_amdgcn_s_getreg((3 << 11) | 20) & 0xFu; }
#define XB_SPIN(cond, bar) do { unsigned _sp = 0; while (cond) { __builtin_amdgcn_s_sleep(1); \
    if ((++_sp & 255u) == 0u) { if (xb_ld(&(bar)[XB_TMO])) break; if (_sp > XB_SPIN_CAP) { atomicAdd(&(bar)[XB_TMO], 1u); break; } } } } while (0)

struct XcdBarrier {
    unsigned* bar; unsigned x;
    volatile LAS unsigned* st;
};

__device__ __forceinline__ XcdBarrier xcd_barrier_post(unsigned* bar, volatile LAS unsigned* st) {
    XcdBarrier b; b.bar = bar; b.x = xb_xcc_id(); b.st = st;
    if (threadIdx.x == 0) (void)xb_add(&bar[XB_XCNT(b.x)], 1u);
    return b;
}
__device__ __forceinline__ void xcd_barrier_complete(unsigned* bar, unsigned x, unsigned& nloc, unsigned& nx) {
    const unsigned G = gridDim.x * gridDim.y * gridDim.z;
    unsigned sum, cnt, mine, sp = 0u;
    for (;;) {
        sum = 0u; cnt = 0u; mine = 0u;
#pragma unroll
        for (unsigned j = 0; j < 16; ++j) { const unsigned c = xb_ld(&bar[XB_XCNT(j)]); sum += c; cnt += (c > 0u) ? 1u : 0u; mine = (j == x) ? c : mine; }
        if (sum == G) break;
        __builtin_amdgcn_s_sleep(1);
        if ((++sp & 255u) == 0u) { if (xb_ld(&bar[XB_TMO])) break; if (sp > XB_SPIN_CAP) { atomicAdd(&bar[XB_TMO], 1u); break; } }
    }
    nloc = mine > 0u ? mine : 1u; nx = cnt > 0u ? cnt : 1u;
}

__device__ __forceinline__ void xcd_barrier(const XcdBarrier& b, int wave0) {
    int l0_; asm volatile("v_mbcnt_lo_u32_b32 %0, -1, 0\n\tv_mbcnt_hi_u32_b32 %0, -1, %0" : "=v"(l0_));
    const bool leader_ = (wave0 == 0) && (l0_ == 0);
    asm volatile("s_waitcnt vmcnt(0)" ::: "memory");
    __syncthreads();
    if (leader_) {
        unsigned* bar = b.bar;
        __builtin_amdgcn_s_waitcnt(0);
        unsigned nloc = b.st[0], nx = b.st[1];
        if (nloc == 0u) { xcd_barrier_complete(bar, b.x, nloc, nx); b.st[0] = nloc; b.st[1] = nx; }
        const unsigned old = xb_add(&bar[XB_XSUB(b.x)], 1u);
        const unsigned gen = old / nloc;
        if (old + 1u == (gen + 1u) * nloc) {
            __builtin_amdgcn_fence(__ATOMIC_RELEASE, "agent");
            asm volatile("s_waitcnt vmcnt(0)" ::: "memory");
            const unsigned og = xb_add(&bar[XB_TOP], 1u);
            const unsigned tg = og / nx;
            if (og + 1u == (tg + 1u) * nx) xb_add(&bar[XB_TOPGEN], 1u);
            else XB_SPIN(xb_ld(&bar[XB_TOPGEN]) == tg, bar);
            __builtin_amdgcn_fence(__ATOMIC_ACQUIRE, "agent");
            xb_add(&bar[XB_XGEN(b.x)], 1u);
            asm volatile("s_waitcnt vmcnt(0)" ::: "memory");
        } else {
            XB_SPIN(xb_ld(&bar[XB_XGEN(b.x)]) == gen, bar);
            __builtin_amdgcn_fence(__ATOMIC_ACQUIRE, "agent");
            asm volatile("s_waitcnt vmcnt(0)" ::: "memory");
        }
    }
    __syncthreads();
}


typedef const __attribute__((address_space(4))) Params* KernargP;
#define PHASE_BEGIN() KernargP kp_ = (KernargP)__builtin_amdgcn_kernarg_segment_ptr(); asm volatile("" : "+s"(kp_)); const Params& p = *(const Params*)kp_; \
    int lane_; asm volatile("v_mbcnt_lo_u32_b32 %0, -1, 0\n\tv_mbcnt_hi_u32_b32 %0, -1, %0" : "=v"(lane_)); const int wave_ = wave0; const int tid_ = wave_ * 64 + lane_; \
    const int G_ = gridDim.x, bx = blockIdx.x; const int gw_ = bx * NWAVES + wave_, NGW = G_ * NWAVES, gt_ = bx * NT + tid_, GT = G_ * NT; \
    LAS float* scr_ = (LAS float*)(lds + wave_ * 16384); float* SSb = (float*)(p.ws + WS_SS); bf16_t* XN = (bf16_t*)(p.ws + WS_XN); \
    (void)lane_; (void)gw_; (void)NGW; (void)gt_; (void)GT; (void)scr_; (void)SSb; (void)XN;
#define GRID_BAR() do { KernargP kb_ = (KernargP)__builtin_amdgcn_kernarg_segment_ptr(); asm volatile("" : "+s"(kb_)); XcdBarrier b_; b_.bar = (unsigned*)(((const Params*)kb_)->ws + WS_CTL); b_.x = xb_xcc_id(); \
    b_.st = (volatile LAS unsigned*)(lds + MISC_OFF); xcd_barrier(b_, wave0); } while (0)
template <int l>
__device__ __forceinline__ void layer_body(LAS unsigned char* lds, const int wave0) {
        { PHASE_BEGIN(); const float* SSmix = SSb + (size_t)(2 * l) * 4 * M;
          { pg8::Gemm g{XN, (const bf16_t*)(p.ws + WS_WIN + (size_t)l * WS_WL1), M, NP, D}; pg8::StaticOrder S; S.init(M, NP, G_, bx);
            EpiIn E{(bf16_t*)(p.ws + WS_P), SSmix};
            pg8::gemm_phase<EpiIn, pg8::StaticOrder, false, true>(lds, g, S, E, tid_); }
        }
        { PHASE_BEGIN(); gates_rows(p, l, SSb + (size_t)(2 * l) * 4 * M, gw_, NGW, lane_); }
        GRID_BAR();
        { PHASE_BEGIN(); const int grp = wave_ >> 1, tl = tid_ & 127;
          for (int i = 0; ; ++i) { if (bx + 4 * i * G_ >= NUNIT) break; int u = bx + (4 * i + grp) * G_; const bool valid = u < NUNIT; if (!valid) u = NUNIT - 1;
              b1_chunk_unit(p, l, u, valid, lds + grp * B1_LDS, tl); }
        }
        GRID_BAR();
        { PHASE_BEGIN(); b2_scan_pool(p, l, lds, bx, G_, tid_); }
        GRID_BAR();
        { PHASE_BEGIN(); const int grp = wave_ >> 2, tl = tid_ & 255;
          for (int i = 0; ; ++i) { if (bx + 2 * i * G_ >= NUNIT) break; int u = bx + (2 * i + grp) * G_; const bool valid = u < NUNIT; if (!valid) u = NUNIT - 1;
              b3_chunk_unit(p, l, u, valid, lds + grp * B3_LDS, tl); } }
        GRID_BAR();
        { PHASE_BEGIN();
          pg8::Gemm g{(const bf16_t*)(p.ws + WS_HCAT), (const bf16_t*)(p.ws + WS_WOUT + (size_t)l * WS_WL1), M, D, D}; pg8::StaticOrder S; S.init(M, D, G_, bx);
          EpiRes E{XN, SSb + (size_t)(2 * l + 1) * 4 * M};
          pg8::gemm_phase<EpiRes, pg8::StaticOrder, true, true>(lds, g, S, E, tid_); }
        GRID_BAR();
        { PHASE_BEGIN();
          pg8::Gemm g{XN, (const bf16_t*)(p.ws + WS_WUP + (size_t)l * WS_WL1), M, 2 * DFF, D}; pg8::StaticOrder S; S.init(M, 2 * DFF, G_, bx, 4);
          { const float* SSn = SSb + (size_t)(2 * l + 1) * 4 * M; LAS float* rsT = (LAS float*)(lds + RST_OFF);
            for (int i = 0; i < 6; ++i) { pg8::Unit uu; if (!S.next(i, uu)) break; if (tid_ < 256) rsT[i * 256 + tid_] = rsqrtf(ss_row(SSn, uu.pm * 256 + tid_) * (1.f / D) + EPS); }
            __syncthreads(); }
          EpiUp E{(bf16_t*)(p.ws + WS_ACT), SSb + (size_t)(2 * l + 1) * 4 * M, p.in[11] + (size_t)l * 3 * 2 * DFF, p.in[12] + (size_t)l * 2 * DFF, (float*)(p.ws + WS_HEAD), (float*)(p.ws + WS_TAIL)};
          pg8::gemm_phase<EpiUp, pg8::StaticOrder, true, true>(lds, g, S, E, tid_);
          { const int NU = 64 * 22, nmax = (NU + G_ - 1) / G_, b0 = NU - (nmax - 1) * G_;
            int ib = bx - b0, nb = G_ - b0; if (nb <= 0) { ib = bx; nb = G_; }
            if (ib >= 0) { const int cgw = ib * NWAVES + wave_, cng = nb * NWAVES;
                if (l == 0) { convert_weights(p, 0, 8, cgw, cng, scr_, lane_); convert_weights(p, 1, 7, cgw, cng, scr_, lane_); }
                else convert_weights(p, 1, 8, cgw, cng, scr_, lane_); } } }
        GRID_BAR();
        { PHASE_BEGIN();
          pg8::Gemm g{(const bf16_t*)(p.ws + WS_ACT), (const bf16_t*)(p.ws + WS_WDN + (size_t)l * WS_WL1), M, D, DFF}; pg8::StaticOrder S; S.init(M, D, G_, bx);
          EpiRes E{XN, SSb + (size_t)(2 * l + 2) * 4 * M};
          { pg8::Unit uu; for (int i = 0; S.next(i, uu); ++i) ffn_fixup_tile(p, l, uu.pm, tid_);
            asm volatile("s_waitcnt vmcnt(0)" ::: "memory"); __syncthreads(); }
          if (l == 1 && G_ == 256) { EpiFinal EF{XN, p.out, p.in[14], (float*)(p.ws + WS_FSLOT), (unsigned*)(p.ws + WS_FCNT)};
              pg8::gemm_phase<EpiFinal, pg8::StaticOrder, true, true>(lds, g, S, EF, tid_); }
          else pg8::gemm_phase<EpiRes, pg8::StaticOrder, true, true>(lds, g, S, E, tid_); }
        if (!(l == 1 && gridDim.x == 256)) GRID_BAR();
}

__global__ void __launch_bounds__(NT, 2) hymba_fwd(Params p_arg) {
    extern __shared__ __attribute__((aligned(16))) unsigned char lds_raw[];
    cg::grid_group grid = cg::this_grid();
    LAS unsigned char* lds = (LAS unsigned char*)lds_raw;
    const int wave0 = __builtin_amdgcn_readfirstlane((int)threadIdx.x >> 6);
    if (threadIdx.x < 2) ((volatile LAS unsigned*)(lds + MISC_OFF))[threadIdx.x] = 0u;
    __syncthreads();
    (void)xcd_barrier_post((unsigned*)(p_arg.ws + WS_CTL), (volatile LAS unsigned*)(lds + MISC_OFF));
    if (p_arg.ws == nullptr) grid.sync();

    { PHASE_BEGIN();
      convert_weights(p, 0, 7, gw_, NGW, scr_, lane_);
      for (int i = gt_; i < 2 * 16384; i += GT) { const int l = i >> 14, j = (i >> 10) & 15, k = i & 1023; ((bf16_t*)(p.ws + WS_WG))[i] = (j < 8) ? f2bf1(p.in[2][(size_t)l * D * INW + (size_t)k * INW + 1536 + j] * p.in[1][l * D + k]) : (bf16_t)0; }
      for (int i = gt_; i < 2 * 4 * 128 * 128; i += GT) { const int c = i & 127, dc = (i >> 7) & 127, lg = i >> 14; ((bf16_t*)(p.ws + WS_WPT))[i] = f2bf1(p.in[6][(size_t)lg * 16384 + c * 128 + dc]); }
      for (int m0 = gw_ * 4; m0 < M; m0 += NGW * 4) {
          f32x4 v[4][4];
#pragma unroll
          for (int r = 0; r < 4; ++r)
#pragma unroll
              for (int j = 0; j < 4; ++j) v[r][j] = __builtin_nontemporal_load((const f32x4*)(p.in[0] + (size_t)(m0 + r) * D) + lane_ + 64 * j);
#pragma unroll
          for (int r = 0; r < 4; ++r) { float s = 0.f;
#pragma unroll
              for (int j = 0; j < 4; ++j) { const f32x4 x = v[r][j]; s += (x[0] * x[0] + x[1] * x[1]) + (x[2] * x[2] + x[3] * x[3]);
                  u32x2 o; o.x = pk_bf16(x[0], x[1]); o.y = pk_bf16(x[2], x[3]); *((u32x2*)(XN + (size_t)(m0 + r) * D) + lane_ + 64 * j) = o; }
              s = wave_sum(s, lane_); if (lane_ == 0) *(f32x4*)(SSb + (size_t)(m0 + r) * 4) = (f32x4){s, 0.f, 0.f, 0.f}; }
      } }
    GRID_BAR();

    layer_body<0>(lds, wave0);
    layer_body<1>(lds, wave0);
    if (gridDim.x != 256) { PHASE_BEGIN(); const float* SSf = SSb + (size_t)4 * 4 * M; const float* gf = p.in[14];
      f32x4 gg[4];
#pragma unroll
      for (int j = 0; j < 4; ++j) gg[j] = *((const f32x4*)gf + lane_ + 64 * j);
      for (int m0 = gw_ * 4; m0 < M; m0 += NGW * 4) {
          u32x2 v[4][4]; float rs[4];
#pragma unroll
          for (int r = 0; r < 4; ++r) { rs[r] = ss_row(SSf, m0 + r);
#pragma unroll
              for (int j = 0; j < 4; ++j) v[r][j] = __builtin_nontemporal_load((const u32x2*)(XN + (size_t)(m0 + r) * D) + lane_ + 64 * j); }
#pragma unroll
          for (int r = 0; r < 4; ++r) { const float sc = rsqrtf(rs[r] * (1.f / D) + EPS);
#pragma unroll
              for (int j = 0; j < 4; ++j) { const f32x4 x = (f32x4){bf_lo(v[r][j].x), bf_hi(v[r][j].x), bf_lo(v[r][j].y), bf_hi(v[r][j].y)};
                  __builtin_nontemporal_store(x * sc * gg[j], (f32x4*)(p.out + (size_t)(m0 + r) * D) + lane_ + 64 * j); } }
      } }
}

extern "C" void kernel_launch(void* const* d_in, const int* in_sizes, int n_in, void* d_out, int out_size, void* d_ws, size_t ws_size, hipStream_t stream) {
    static int grid = 0;
    if (grid == 0) {
        if (n_in != 15 || in_sizes[0] != M * D || out_size != M * D || ws_size < WS_END) { fprintf(stderr, "kernel_launch: unexpected shapes (n_in %d, in0 %d, out %d, ws %zu)\n", n_in, n_in > 0 ? in_sizes[0] : -1, out_size, ws_size); grid = -1; return; }
        int dev = 0, cus = 0, per_cu = 0;
        if (hipGetDevice(&dev) != hipSuccess || hipDeviceGetAttribute(&cus, hipDeviceAttributeMultiprocessorCount, dev) != hipSuccess) { grid = -1; return; }
        if (hipFuncSetAttribute((const void*)hymba_fwd, hipFuncAttributeMaxDynamicSharedMemorySize, LDS_BYTES) != hipSuccess) { fprintf(stderr, "kernel_launch: hipFuncSetAttribute failed\n"); grid = -1; return; }
        if (hipOccupancyMaxActiveBlocksPerMultiprocessor(&per_cu, (const void*)hymba_fwd, NT, LDS_BYTES) != hipSuccess || per_cu < 1) { fprintf(stderr, "kernel_launch: occupancy query says %d blocks per CU\n", per_cu); per_cu = 1; }
        (void)hipGetLastError();
        grid = cus * per_cu;
    }
    if (grid < 0) return;
    if (hipMemsetAsync((char*)d_ws + WS_CTL, 0, 32768, stream) != hipSuccess) { fprintf(stderr, "kernel_launch: memset failed\n"); return; }
    Params p{};
    for (int i = 0; i < 15; ++i) p.in[i] = (const float*)d_in[i];
    p.out = (float*)d_out; p.ws = (unsigned char*)d_ws;
    void* args[] = {&p};
    hipError_t e = hipLaunchCooperativeKernel((const void*)hymba_fwd, dim3(grid), dim3(NT), args, LDS_BYTES, stream);
    if (e != hipSuccess) fprintf(stderr, "kernel_launch: cooperative launch failed: %s (grid %d)\n", hipGetErrorString(e), grid);
}
```
